# Optimizing an MI355X kernel written in HIP

```python
import jax, jax.numpy as jnp
from jax import lax
import numpy as np

D_MODEL = 2048
BATCH = 1
SEQ = 16384
DEPTH = 1

EPS = 1e-6
N_MOD = 6
POOL_WINDOWS = (2, 4, 8, 16)
POOL_GROUPS = 4
POOL_WIDTH = D_MODEL
POOL_GDIM = POOL_WIDTH // POOL_GROUPS
RET_HEADS = 8
RET_DK = D_MODEL // RET_HEADS
RET_DV = 2 * RET_DK
RET_QK_WIDTH = RET_HEADS * RET_DK
RET_V_WIDTH = RET_HEADS * RET_DV
RET_CHUNK = 128
ROPE_BASE = 10000.0
SPLITS = (POOL_WIDTH, RET_QK_WIDTH, RET_QK_WIDTH, RET_V_WIDTH, RET_V_WIDTH, D_MODEL, D_MODEL)
IN_COLS = sum(SPLITS)
PEER_HEADS = 8
PEER_NKEYS = 128
PEER_N_EXPERTS = PEER_NKEYS * PEER_NKEYS
PEER_QDIM = 256
PEER_HALF = PEER_QDIM // 2
PEER_TOPK_HALF = 16
PEER_TOPK = 16
PEER_TOKEN_BLOCK = 128

kernel_name = 'hybrid_pool_retention_peer_adaln'


def rmsnorm(x, gain):
    xf = x.astype(jnp.float32)
    y = xf * lax.rsqrt(jnp.mean(xf * xf, axis=-1, keepdims=True) + EPS)
    return (y * gain.astype(jnp.float32)).astype(x.dtype)


def modulate(xn, shift, scale):
    return xn * (1 + scale[:, None, :]) + shift[:, None, :]


def head_layernorm(y, gain):
    B, S, H, dv = y.shape
    yf = y.astype(jnp.float32)
    mu = jnp.mean(yf, axis=-1, keepdims=True)
    var = jnp.mean(jnp.square(yf - mu), axis=-1, keepdims=True)
    yn = ((yf - mu) * lax.rsqrt(var + EPS)).reshape(B, S, H * dv)
    return (yn * gain.astype(jnp.float32)).astype(y.dtype)


def causal_window_mean(u, w):
    S = u.shape[1]
    cs = jnp.cumsum(u.astype(jnp.float32), axis=1)
    lag = jnp.pad(cs, ((0, 0), (w, 0), (0, 0)))[:, :S]
    count = jnp.minimum(jnp.arange(1, S + 1), w).astype(jnp.float32)
    return ((cs - lag) / count[None, :, None]).astype(u.dtype)


def pool_mixer(u, pool_w, pool_scale):
    B, S, _ = u.shape
    ug = u.reshape(B, S, POOL_GROUPS, POOL_GDIM)
    pooled = jnp.stack(
        [causal_window_mean(ug[:, :, g], w) - ug[:, :, g] for g, w in enumerate(POOL_WINDOWS)], axis=2)
    mixed = jnp.einsum('bsgc,gcd->bsgd', pooled, pool_w)
    return mixed.reshape(B, S, POOL_WIDTH) * pool_scale


def rotary(t, positions):
    dh = t.shape[-1]
    inv_freq = ROPE_BASE ** (-jnp.arange(0, dh, 2, dtype=jnp.float32) / dh)
    ang = positions.astype(jnp.float32)[..., None] * inv_freq
    cos = jnp.cos(ang)[:, :, None, :].astype(t.dtype)
    sin = jnp.sin(ang)[:, :, None, :].astype(t.dtype)
    t1, t2 = jnp.split(t, 2, axis=-1)
    return jnp.concatenate([t1 * cos - t2 * sin, t2 * cos + t1 * sin], axis=-1)


def retention(q, k, v):
    B, S, H, dk = q.shape
    dv = v.shape[-1]
    C = RET_CHUNK
    nC = S // C
    log_g = jnp.log(1.0 - 2.0 ** (-5.0 - jnp.arange(H, dtype=jnp.float32)))
    idx = jnp.arange(C, dtype=jnp.float32)
    diff = idx[:, None] - idx[None, :]
    decay_intra = jnp.where(diff[None] >= 0,
                            jnp.exp(jnp.maximum(diff, 0.0)[None] * log_g[:, None, None]), 0.0)
    q_dec = jnp.exp((idx + 1.0)[None, :] * log_g[:, None])
    k_dec = jnp.exp((C - 1.0 - idx)[None, :] * log_g[:, None])
    chunk_dec = jnp.exp(C * log_g)

    def to_chunks(t):
        return t.reshape(B, nC, C, H, t.shape[-1]).transpose(1, 0, 3, 2, 4)

    def step(state, inp):
        qi, ki, vi = inp
        scores = jnp.einsum('bhid,bhjd->bhij', qi, ki) * decay_intra
        inner = jnp.einsum('bhij,bhjv->bhiv', scores, vi)
        cross = jnp.einsum('bhid,bhdv->bhiv', qi * q_dec[None, :, :, None], state)
        new_state = state * chunk_dec[None, :, None, None] + jnp.einsum(
            'bhjd,bhjv->bhdv', ki * k_dec[None, :, :, None], vi)
        return new_state, inner + cross

    state0 = jnp.zeros((B, H, dk, dv), jnp.float32)
    _, out = lax.scan(step, state0, (to_chunks(q), to_chunks(k), to_chunks(v)))
    return out.transpose(1, 0, 3, 2, 4).reshape(B, S, H, dv).astype(v.dtype)


def peer_ffn(xn, w_query, sub_keys, expert_u, expert_v):
    B, S, D = xn.shape
    q = (xn @ w_query).reshape(B, S, PEER_HEADS, 2, PEER_HALF)
    s = jnp.einsum('bshpc,hpnc->bshpn', q, sub_keys)
    top_s, top_i = lax.top_k(s, PEER_TOPK_HALF)
    cand_s = (top_s[..., 0, :, None] + top_s[..., 1, None, :]).reshape(B, S, PEER_HEADS, -1)
    cand_e = (top_i[..., 0, :, None] * PEER_NKEYS + top_i[..., 1, None, :]).reshape(B, S, PEER_HEADS, -1)
    best_s, best_pos = lax.top_k(cand_s, PEER_TOPK)
    experts = jnp.take_along_axis(cand_e, best_pos, axis=-1)
    gates = jax.nn.softmax(best_s.astype(jnp.float32), axis=-1).astype(xn.dtype)
    T = B * S
    nb = T // PEER_TOKEN_BLOCK
    xt = xn.reshape(nb, PEER_TOKEN_BLOCK, D)
    et = experts.reshape(nb, PEER_TOKEN_BLOCK, PEER_HEADS * PEER_TOPK)
    gt = gates.reshape(nb, PEER_TOKEN_BLOCK, PEER_HEADS * PEER_TOPK)

    def block(args):
        xb, eb, gb = args
        u = expert_u[eb]
        v = expert_v[eb]
        act = jax.nn.gelu(jnp.einsum('td,tkd->tk', xb, u))
        return jnp.einsum('tk,tkd->td', gb * act, v)

    out = lax.map(block, (xt, et, gt))
    return out.reshape(B, S, D)


def setup_inputs(seed: int = 0) -> dict:
    key = jax.random.key(seed)
    ks = jax.random.split(key, 18)
    L = DEPTH
    D = D_MODEL

    def nrm(k, shape, scale):
        return jax.random.normal(k, shape, jnp.float32) * scale

    return {
        'x': nrm(ks[0], (BATCH, SEQ, D), 1.0),
        'c': nrm(ks[1], (BATCH, D), 1.0),
        'positions': jnp.broadcast_to(jnp.arange(SEQ, dtype=jnp.int32), (BATCH, SEQ)),
        'norm_mix_gain': 1.0 + nrm(ks[2], (L, D), 0.02),
        'w_ada': nrm(ks[3], (L, D, N_MOD * D), 0.5 * D ** -0.5),
        'b_ada': nrm(ks[4], (L, N_MOD * D), 0.02),
        'w_in': nrm(ks[5], (L, D, IN_COLS), D ** -0.5),
        'pool_w': nrm(ks[6], (L, POOL_GROUPS, POOL_GDIM, POOL_GDIM), POOL_GDIM ** -0.5),
        'pool_scale': 1.0 + nrm(ks[7], (L, POOL_WIDTH), 0.02),
        'ret_norm_gain': 1.0 + nrm(ks[8], (L, RET_V_WIDTH), 0.02),
        'w_branch_pool': nrm(ks[9], (L, POOL_WIDTH, D), POOL_WIDTH ** -0.5),
        'w_branch_ret': nrm(ks[10], (L, RET_V_WIDTH, D), RET_V_WIDTH ** -0.5),
        'w_out': nrm(ks[11], (L, D, D), D ** -0.5),
        'norm_ffn_gain': 1.0 + nrm(ks[12], (L, D), 0.02),
        'peer_w_query': nrm(ks[13], (L, D, PEER_HEADS * PEER_QDIM), D ** -0.5),
        'peer_sub_keys': nrm(ks[14], (L, PEER_HEADS, 2, PEER_NKEYS, PEER_HALF), PEER_HALF ** -0.5),
        'peer_u': nrm(ks[15], (L, PEER_N_EXPERTS, D), D ** -0.5),
        'peer_v': nrm(ks[16], (L, PEER_N_EXPERTS, D), PEER_HEADS ** -0.5),
        'final_norm_gain': 1.0 + nrm(ks[17], (D,), 0.02),
    }


def reference(x, c, positions, norm_mix_gain, w_ada, b_ada, w_in, pool_w, pool_scale, ret_norm_gain,
              w_branch_pool, w_branch_ret, w_out, norm_ffn_gain, peer_w_query, peer_sub_keys, peer_u, peer_v,
              final_norm_gain):
    B, S, _ = x.shape
    cond = jax.nn.silu(c)
    split_points = [int(p) for p in np.cumsum(SPLITS)[:-1]]
    for l in range(DEPTH):
        mod = cond @ w_ada[l] + b_ada[l]
        sh1, sc1, g1, sh2, sc2, g2 = jnp.split(mod, N_MOD, axis=-1)
        hn = modulate(rmsnorm(x, norm_mix_gain[l]), sh1, sc1)
        proj = hn @ w_in[l]
        u_pool, q, k, v, g_ret, a_pool, a_ret = jnp.split(proj, split_points, axis=-1)
        pool_out = pool_mixer(u_pool, pool_w[l], pool_scale[l])
        q = rotary(q.reshape(B, S, RET_HEADS, RET_DK), positions)
        k = rotary(k.reshape(B, S, RET_HEADS, RET_DK), positions) * (RET_DK ** -0.5)
        y = retention(q, k, v.reshape(B, S, RET_HEADS, RET_DV))
        ret_out = jax.nn.silu(g_ret) * head_layernorm(y, ret_norm_gain[l])
        merged = (jax.nn.sigmoid(a_pool) * (pool_out @ w_branch_pool[l])
                  + jax.nn.sigmoid(a_ret) * (ret_out @ w_branch_ret[l]))
        x = x + g1[:, None, :] * (merged @ w_out[l])
        fn = modulate(rmsnorm(x, norm_ffn_gain[l]), sh2, sc2)
        x = x + g2[:, None, :] * peer_ffn(fn, peer_w_query[l], peer_sub_keys[l], peer_u[l], peer_v[l])
    return rmsnorm(x, final_norm_gain)
```

```cpp
#include <hip/hip_runtime.h>
#include <hip/hip_cooperative_groups.h>
#include <cstdio>
#include <cstdint>
namespace cg = cooperative_groups;

#ifndef MK_N_LAUNCHES
#define MK_N_LAUNCHES 0
#endif

#define LAS __attribute__((address_space(3)))
typedef unsigned short bf16_t;
typedef short bf16x8 __attribute__((ext_vector_type(8)));
typedef float f32x4 __attribute__((ext_vector_type(4)));
typedef float f32x2 __attribute__((ext_vector_type(2)));
typedef unsigned u32x4 __attribute__((ext_vector_type(4)));
typedef unsigned u32x2 __attribute__((ext_vector_type(2)));

constexpr int S = 16384, D = 2048, NIN = 18432, RH = 8, DK = 256, DV = 512, VW = 4096, NE = 16384;
constexpr float EPS = 1e-6f;
constexpr int NPHASE = 10;

constexpr size_t MiB = 1u << 20;
constexpr size_t WS_CTL = 0;
constexpr size_t WS_WOUT = 1 * MiB;
constexpr size_t WS_WQS = 9 * MiB;
constexpr size_t WS_WIN = 17 * MiB;
constexpr size_t WS_POOLED = WS_WIN;
constexpr size_t WS_UPOOL = 89 * MiB;
constexpr size_t WS_MERGED = WS_UPOOL;
constexpr size_t WS_Q = 153 * MiB;
constexpr size_t WS_K = 217 * MiB;
constexpr size_t WS_UTAB = WS_Q;
constexpr size_t WS_VTAB = WS_K;
constexpr size_t WS_V = 281 * MiB;
constexpr size_t WS_SCORES = WS_V;
constexpr size_t WS_GRET = 409 * MiB;
constexpr size_t WS_FN = WS_GRET;
constexpr size_t WS_SAP = 537 * MiB;
constexpr size_t WS_SAR = 601 * MiB;
constexpr size_t WS_END = 665 * MiB;
constexpr size_t DO_HN = 0;
constexpr size_t DO_RCOS = 64 * MiB;
constexpr size_t DO_RSIN = 72 * MiB;
constexpr size_t DO_WPC = 80 * MiB;
constexpr size_t DO_PRET = 88 * MiB;

constexpr int LDS_BYTES = 147456;

__device__ __forceinline__ unsigned f2bf(float f) { unsigned u = __builtin_bit_cast(unsigned, f); return (u + 0x7fffu + ((u >> 16) & 1u)) >> 16; }
__device__ __forceinline__ unsigned pk2(float lo, float hi) { return f2bf(lo) | (f2bf(hi) << 16); }
__device__ __forceinline__ float bf_lo(unsigned u) { return __builtin_bit_cast(float, u << 16); }
__device__ __forceinline__ float bf_hi(unsigned u) { return __builtin_bit_cast(float, u & 0xffff0000u); }
__device__ __forceinline__ float wave_sum(float v) {
#pragma unroll
    for (int o = 1; o < 64; o <<= 1) v += __shfl_xor(v, o);
    return v;
}
#define LDS_WAIT() asm volatile("s_waitcnt lgkmcnt(0)" ::: "memory")
constexpr double MOD_FX = 1099511627776.0;
__device__ __forceinline__ float modval(const long long* macc, const float* b_ada, int i) { return (float)((double)macc[i] * (1.0 / MOD_FX)) + b_ada[i]; }

namespace pg8 {
constexpr int BM = 256, BK = 64, HALF = 128, HTB = HALF * BK * 2, STAGE_BYTES = 8 * HTB, NXCD = 8, WGM = 8;
__host__ __device__ __forceinline__ int lds_byte(int r, int c) { const int st = (r >> 4) * 2 + (c >> 5), rr = r & 15, cc = c & 31, ob = rr * 64 + cc * 2; return st * 1024 + (ob ^ (((ob >> 9) & 1) << 5)); }
__host__ __device__ __forceinline__ void stage_rc(int b, int& R, int& C) { const int st = b / 1024, sb = b % 1024, swz = sb ^ (((sb >> 9) & 1) << 5); R = (st >> 1) * 16 + swz / 64; C = (st & 1) * 32 + (swz % 64) / 2; }
__host__ __device__ __forceinline__ int perm32(int rho) { const int n = rho >> 4, i = rho & 15; return 8 * (i >> 2) + 4 * n + (i & 3); }
struct Unit { int pm, pn; };
struct Gemm { const bf16_t* A; const bf16_t* Bt; int M, N, K; };
struct StaticOrder {
    int nM, nN, nwg, G, c;
    __host__ __device__ void init(int M, int N, int G_, int c_) { nM = M / BM; nN = N / BM; nwg = nM * nN; G = G_; c = c_; }
    __host__ __device__ bool next(int i, Unit& u) const {
        const long L = (long)i * G + c; if (L >= nwg) return false;
        int wgid = (int)L; { const int q = nwg / NXCD, r = nwg % NXCD, xcd = wgid % NXCD, off = wgid / NXCD; wgid = (xcd < r ? xcd * (q + 1) : r * (q + 1) + (xcd - r) * q) + off; }
        const int nig = WGM * nN, gid = wgid / nig, fm = gid * WGM, gsz = (nM - fm) < WGM ? (nM - fm) : WGM;
        u.pm = fm + ((wgid % nig) % gsz); u.pn = (wgid % nig) / gsz; return true;
    }
};
template <class Epi>
__device__ __forceinline__ void gemm_phase(LAS unsigned char* lds, const Gemm g, const StaticOrder& S, const Epi& E) {
    const int tid = threadIdx.x, wid = __builtin_amdgcn_readfirstlane(tid >> 6), lane = tid & 63, wr = wid >> 2, wc = wid & 3, fr = lane & 15, fq = lane >> 4;
    const int K = g.K, nt = K / BK;
    unsigned voffA[2], voffB[2];
#pragma unroll
    for (int i = 0; i < 2; ++i) { int R, C; stage_rc(tid * 16 + i * 8192, R, C); const int Rb = Epi::PERM ? ((R & ~31) + perm32(R & 31)) : R;
        voffA[i] = (unsigned)(R * K + C) * 2u; voffB[i] = (unsigned)(Rb * K + C) * 2u; }
    const size_t kstep = (size_t)(BK * 2);
    const size_t hstep = (size_t)HALF * K * 2;
    const size_t tstep = 2 * hstep;
    const unsigned ldsw = (unsigned)wid * 1024u;
    const int aoff = lds_byte(wr * 64 + fr, fq * 8), boff = lds_byte(wc * 32 + fr, fq * 8);
#define PG8_SA(b, h) (((b) * 2 + (h)) * HTB)
#define PG8_SB(b, h) ((4 + (b) * 2 + (h)) * HTB)
#define PG8_STAGE(bufoff, gbase, voff) do { _Pragma("unroll") for (int _i = 0; _i < 2; ++_i) \
        __builtin_amdgcn_global_load_lds((const unsigned*)((const char*)(gbase) + (voff)[_i]), (LAS unsigned*)(lds + (bufoff) + ldsw + _i * 8192), 16, 0, 0); } while (0)
#define PG8_LDA(dst, b, h) do { _Pragma("unroll") for (int m = 0; m < 4; ++m) _Pragma("unroll") for (int k = 0; k < 2; ++k) dst[m][k] = *(const LAS bf16x8*)(lds + PG8_SA(b, h) + aoff + m * 2048 + k * 1024); } while (0)
#define PG8_LDB(dst, b, h) do { _Pragma("unroll") for (int n = 0; n < 2; ++n) _Pragma("unroll") for (int k = 0; k < 2; ++k) dst[n][k] = *(const LAS bf16x8*)(lds + PG8_SB(b, h) + boff + n * 2048 + k * 1024); } while (0)
#define PG8_MMA(ai, bj, At, Bt) do { __builtin_amdgcn_s_setprio(1); _Pragma("unroll") for (int m = 0; m < 4; ++m) _Pragma("unroll") for (int n = 0; n < 2; ++n) _Pragma("unroll") for (int k = 0; k < 2; ++k) \
        acc[ai][bj][m][n] = __builtin_amdgcn_mfma_f32_16x16x32_bf16(Bt[n][k], At[m][k], acc[ai][bj][m][n], 0, 0, 0); __builtin_amdgcn_s_setprio(0); } while (0)
#define PG8_WAIT_V(n) asm volatile("s_waitcnt vmcnt(" #n ")" ::: "memory")
#define PG8_WAIT_L(n) asm volatile("s_waitcnt lgkmcnt(" #n ")" ::: "memory")
#define PG8_BAR __builtin_amdgcn_s_barrier()
#define PG8_SCHED __builtin_amdgcn_sched_barrier(0)
    Unit cur, nxt; int ui = 0;
    if (!S.next(0, cur)) return;
    f32x4 acc[2][2][4][2];
#pragma unroll
    for (int a = 0; a < 2; ++a)
#pragma unroll
        for (int b = 0; b < 2; ++b)
#pragma unroll
            for (int m = 0; m < 4; ++m)
#pragma unroll
                for (int n = 0; n < 2; ++n) acc[a][b][m][n] = (f32x4){0.f, 0.f, 0.f, 0.f};
    bf16x8 At[4][2], B0[2][2], B1[2][2];
    const char* cA = (const char*)g.A + (size_t)cur.pm * tstep; const char* cB = (const char*)g.Bt + (size_t)cur.pn * tstep;
    PG8_STAGE(PG8_SB(0, 0), cB, voffB); PG8_STAGE(PG8_SA(0, 0), cA, voffA); PG8_STAGE(PG8_SB(0, 1), cB + hstep, voffB); PG8_STAGE(PG8_SA(0, 1), cA + hstep, voffA);
    if (wr == 1) PG8_BAR;
    PG8_WAIT_V(4); PG8_BAR;
    PG8_STAGE(PG8_SB(1, 0), cB + kstep, voffB); PG8_STAGE(PG8_SA(1, 0), cA + kstep, voffA); PG8_STAGE(PG8_SB(1, 1), cB + hstep + kstep, voffB);
    PG8_WAIT_V(6); PG8_BAR;
    for (;;) {
        const bool has_next = S.next(ui + 1, nxt);
        const char* nA = has_next ? (const char*)g.A + (size_t)nxt.pm * tstep : cA; const char* nB = has_next ? (const char*)g.Bt + (size_t)nxt.pn * tstep : cB;
        for (int t = 0; t < nt; t += 2) {
            const bool last = (t == nt - 2);
            const char* a1 = cA + (size_t)(t + 1) * kstep;
            const char* a2 = last ? nA : cA + (size_t)(t + 2) * kstep; const char* b2 = last ? nB : cB + (size_t)(t + 2) * kstep;
            const char* a3 = a2 + kstep; const char* b3 = b2 + kstep;
            PG8_LDB(B0, 0, 0); PG8_SCHED; PG8_LDA(At, 0, 0); PG8_STAGE(PG8_SA(1, 1), a1 + hstep, voffA);
            PG8_WAIT_L(8); PG8_BAR; PG8_WAIT_L(0); PG8_MMA(0, 0, At, B0); PG8_BAR; PG8_SCHED;
            PG8_LDB(B1, 0, 1); PG8_STAGE(PG8_SB(0, 0), b2, voffB);
            PG8_BAR; PG8_WAIT_L(0); PG8_MMA(0, 1, At, B1); PG8_BAR;
            PG8_LDA(At, 0, 1); PG8_STAGE(PG8_SA(0, 0), a2, voffA);
            PG8_BAR; PG8_WAIT_L(0); PG8_MMA(1, 0, At, B0); PG8_BAR; PG8_SCHED;
            PG8_STAGE(PG8_SB(0, 1), b2 + hstep, voffB);
            PG8_WAIT_V(6); PG8_BAR; PG8_MMA(1, 1, At, B1); PG8_BAR;
            PG8_LDB(B0, 1, 0); PG8_SCHED; PG8_LDA(At, 1, 0); PG8_STAGE(PG8_SA(0, 1), a2 + hstep, voffA);
            PG8_WAIT_L(8); PG8_BAR; PG8_WAIT_L(0); PG8_MMA(0, 0, At, B0); PG8_BAR; PG8_SCHED;
            PG8_LDB(B1, 1, 1); PG8_STAGE(PG8_SB(1, 0), b3, voffB);
            PG8_BAR; PG8_WAIT_L(0); PG8_MMA(0, 1, At, B1); PG8_BAR;
            PG8_LDA(At, 1, 1); PG8_STAGE(PG8_SA(1, 0), a3, voffA);
            PG8_BAR; PG8_WAIT_L(0); PG8_MMA(1, 0, At, B0); PG8_BAR; PG8_SCHED;
            PG8_STAGE(PG8_SB(1, 1), b3 + hstep, voffB);
            PG8_WAIT_V(6); PG8_BAR; PG8_MMA(1, 1, At, B1); PG8_BAR;
        }
        E(acc, cur, wr, wc, fr, fq);
        if (!has_next) break;
#pragma unroll
        for (int a = 0; a < 2; ++a)
#pragma unroll
            for (int b = 0; b < 2; ++b)
#pragma unroll
                for (int m = 0; m < 4; ++m)
#pragma unroll
                    for (int n = 0; n < 2; ++n) acc[a][b][m][n] = (f32x4){0.f, 0.f, 0.f, 0.f};
        cur = nxt; cA = nA; cB = nB; ++ui;
    }
    PG8_WAIT_V(0);
    if (wr == 0) PG8_BAR;
    PG8_BAR;
#undef PG8_SA
#undef PG8_SB
#undef PG8_STAGE
#undef PG8_LDA
#undef PG8_LDB
#undef PG8_MMA
#undef PG8_WAIT_V
#undef PG8_WAIT_L
#undef PG8_BAR
#undef PG8_SCHED
}
}

struct Args {
    const float* x; const float* c; const int* positions; const float* norm_mix_gain; const float* w_ada; const float* b_ada; const float* w_in;
    const float* pool_w; const float* pool_scale; const float* ret_norm_gain; const float* w_branch_pool; const float* w_branch_ret; const float* w_out;
    const float* norm_ffn_gain; const float* peer_w_query; const float* peer_sub_keys; const float* peer_u; const float* peer_v; const float* final_norm_gain;
    float* out; unsigned char* ws; int ph_lo, ph_hi;
};

__device__ __forceinline__ float sigmoidf_(float x) { return 1.0f / (1.0f + __expf(-x)); }

struct EpiG1 {
    static constexpr bool PERM = true;
    bf16_t *upool, *q, *k, *v, *gret, *sap, *sar; const float *rcos, *rsin;
    __device__ __forceinline__ void operator()(const f32x4 (&acc)[2][2][4][2], const pg8::Unit& u, int wr, int wc, int fr, int fq) const {
        const int pn = u.pn, row0 = u.pm * 256 + wr * 64 + fr, cw = wc * 32 + 8 * fq;
        if (pn >= 8 && pn < 24) {
            bf16_t* base = (pn < 16) ? q : k; const int head = (pn - 8) & 7; const float sc = (pn < 16) ? 1.0f : 0.0625f;
#pragma unroll
            for (int ai = 0; ai < 2; ++ai)
#pragma unroll
                for (int m = 0; m < 4; ++m) {
                    const int row = row0 + ai * 128 + m * 16;
                    const float* cp = rcos + (size_t)row * 128 + cw; const float* sp = rsin + (size_t)row * 128 + cw;
                    const f32x4 c0 = *(const f32x4*)cp, c1 = *(const f32x4*)(cp + 4), s0 = *(const f32x4*)sp, s1 = *(const f32x4*)(sp + 4);
                    const f32x4 a0 = acc[ai][0][m][0], a1 = acc[ai][0][m][1], b0 = acc[ai][1][m][0], b1 = acc[ai][1][m][1];
                    const f32x4 p0 = (a0 * c0 - b0 * s0) * sc, p1 = (a1 * c1 - b1 * s1) * sc, r0 = (b0 * c0 + a0 * s0) * sc, r1 = (b1 * c1 + a1 * s1) * sc;
                    bf16_t* rowp = base + (size_t)row * 2048 + head * 256 + cw;
                    u32x4 w; w.x = pk2(p0[0], p0[1]); w.y = pk2(p0[2], p0[3]); w.z = pk2(p1[0], p1[1]); w.w = pk2(p1[2], p1[3]);
                    *(u32x4*)rowp = w;
                    w.x = pk2(r0[0], r0[1]); w.y = pk2(r0[2], r0[3]); w.z = pk2(r1[0], r1[1]); w.w = pk2(r1[2], r1[3]);
                    *(u32x4*)(rowp + 128) = w;
                }
        } else {
            bf16_t* base; int ldc, col, kind;
            if (pn < 8) { base = upool; ldc = 2048; col = pn * 256; kind = 0; }
            else if (pn < 40) { base = v; ldc = 4096; col = (pn - 24) * 256; kind = 0; }
            else if (pn < 56) { base = gret; ldc = 4096; col = (pn - 40) * 256; kind = 1; }
            else if (pn < 64) { base = sap; ldc = 2048; col = (pn - 56) * 256; kind = 2; }
            else { base = sar; ldc = 2048; col = (pn - 64) * 256; kind = 2; }
#pragma unroll
            for (int ai = 0; ai < 2; ++ai)
#pragma unroll
                for (int m = 0; m < 4; ++m) {
                    bf16_t* rowp = base + (size_t)(row0 + ai * 128 + m * 16) * ldc + col + cw;
#pragma unroll
                    for (int bj = 0; bj < 2; ++bj) {
                        f32x4 v0 = acc[ai][bj][m][0], v1 = acc[ai][bj][m][1];
                        if (kind != 0) {
#pragma unroll
                            for (int j = 0; j < 4; ++j) { const float g0 = sigmoidf_(v0[j]), g1 = sigmoidf_(v1[j]); v0[j] = (kind == 1) ? v0[j] * g0 : g0; v1[j] = (kind == 1) ? v1[j] * g1 : g1; }
                        }
                        u32x4 w; w.x = pk2(v0[0], v0[1]); w.y = pk2(v0[2], v0[3]); w.z = pk2(v1[0], v1[1]); w.w = pk2(v1[2], v1[3]);
                        *(u32x4*)(rowp + bj * 128) = w;
                    }
                }
        }
    }
};

template <int ADD> struct EpiGate {
    static constexpr bool PERM = true;
    const bf16_t* gate; bf16_t* out;
    __device__ __forceinline__ void operator()(const f32x4 (&acc)[2][2][4][2], const pg8::Unit& u, int wr, int wc, int fr, int fq) const {
        const int row0 = u.pm * 256 + wr * 64 + fr, col0 = u.pn * 256 + wc * 32 + 8 * fq;
#pragma unroll
        for (int ai = 0; ai < 2; ++ai)
#pragma unroll
            for (int m = 0; m < 4; ++m) {
                const size_t off = (size_t)(row0 + ai * 128 + m * 16) * 2048 + col0;
#pragma unroll
                for (int bj = 0; bj < 2; ++bj) {
                    const u32x4 gv = *(const u32x4*)(gate + off + bj * 128);
                    f32x4 v0 = acc[ai][bj][m][0], v1 = acc[ai][bj][m][1];
                    v0[0] *= bf_lo(gv.x); v0[1] *= bf_hi(gv.x); v0[2] *= bf_lo(gv.y); v0[3] *= bf_hi(gv.y);
                    v1[0] *= bf_lo(gv.z); v1[1] *= bf_hi(gv.z); v1[2] *= bf_lo(gv.w); v1[3] *= bf_hi(gv.w);
                    if (ADD) { const u32x4 pv = *(const u32x4*)(out + off + bj * 128);
                        v0[0] += bf_lo(pv.x); v0[1] += bf_hi(pv.x); v0[2] += bf_lo(pv.y); v0[3] += bf_hi(pv.y);
                        v1[0] += bf_lo(pv.z); v1[1] += bf_hi(pv.z); v1[2] += bf_lo(pv.w); v1[3] += bf_hi(pv.w); }
                    u32x4 w; w.x = pk2(v0[0], v0[1]); w.y = pk2(v0[2], v0[3]); w.z = pk2(v1[0], v1[1]); w.w = pk2(v1[2], v1[3]);
                    *(u32x4*)(out + off + bj * 128) = w;
                }
            }
    }
};

struct EpiRes {
    static constexpr bool PERM = false;
    const float* x; float* out; const long long* modacc; const float* b_ada;
    __device__ __forceinline__ void operator()(const f32x4 (&acc)[2][2][4][2], const pg8::Unit& u, int wr, int wc, int fr, int fq) const {
        const int row0 = u.pm * 256 + wr * 64 + fr, col0 = u.pn * 256 + wc * 32 + 4 * fq;
        f32x4 gv[2][2];
#pragma unroll
        for (int bj = 0; bj < 2; ++bj)
#pragma unroll
            for (int n = 0; n < 2; ++n) { const int c = 2 * D + col0 + bj * 128 + n * 16; gv[bj][n] = (f32x4){modval(modacc, b_ada, c), modval(modacc, b_ada, c + 1), modval(modacc, b_ada, c + 2), modval(modacc, b_ada, c + 3)}; }
#pragma unroll
        for (int ai = 0; ai < 2; ++ai)
#pragma unroll
            for (int m = 0; m < 4; ++m) {
                const size_t off = (size_t)(row0 + ai * 128 + m * 16) * 2048 + col0;
#pragma unroll
                for (int bj = 0; bj < 2; ++bj)
#pragma unroll
                    for (int n = 0; n < 2; ++n) { const f32x4 xv = *(const f32x4*)(x + off + bj * 128 + n * 16); *(f32x4*)(out + off + bj * 128 + n * 16) = xv + gv[bj][n] * acc[ai][bj][m][n]; }
            }
    }
};

struct EpiF32 {
    static constexpr bool PERM = false;
    float* out;
    __device__ __forceinline__ void operator()(const f32x4 (&acc)[2][2][4][2], const pg8::Unit& u, int wr, int wc, int fr, int fq) const {
        const int row0 = u.pm * 256 + wr * 64 + fr, col0 = u.pn * 256 + wc * 32 + 4 * fq;
#pragma unroll
        for (int ai = 0; ai < 2; ++ai)
#pragma unroll
            for (int m = 0; m < 4; ++m) {
                float* rowp = out + (size_t)(row0 + ai * 128 + m * 16) * 2048 + col0;
#pragma unroll
                for (int bj = 0; bj < 2; ++bj)
#pragma unroll
                    for (int n = 0; n < 2; ++n) *(f32x4*)(rowp + bj * 128 + n * 16) = acc[ai][bj][m][n];
            }
    }
};

__device__ __forceinline__ void transpose_item(const float* W, int K, int N, bf16_t* WT, LAS float* scr, int item, int lane) {
    const int nblk = N / 32, kb = item / nblk, nb = item % nblk, k0 = 64 * kb, n0 = 32 * nb;
#pragma unroll 8
    for (int i = 0; i < 32; ++i) { const int kk = 2 * i + (lane >> 5); scr[kk * 33 + (lane & 31)] = W[(size_t)(k0 + kk) * N + n0 + (lane & 31)]; }
    LDS_WAIT();
    const int c = lane & 7;
#pragma unroll
    for (int j = 0; j < 4; ++j) { const int n = (lane >> 3) + 8 * j; const LAS float* s = scr + (8 * c) * 33 + n;
        u32x4 o; o.x = pk2(s[0 * 33], s[1 * 33]); o.y = pk2(s[2 * 33], s[3 * 33]); o.z = pk2(s[4 * 33], s[5 * 33]); o.w = pk2(s[6 * 33], s[7 * 33]);
        *(u32x4*)(WT + (size_t)(n0 + n) * K + k0 + 8 * c) = o; }
    LDS_WAIT();
}

__device__ __forceinline__ void norm_mod_row(const float* xrow, const float* gain, const LAS float* shl, const LAS float* scl, bf16_t* orow, int lane) {
    const f32x4* xr = (const f32x4*)xrow + lane;
    f32x4 v[8]; float s = 0.f;
#pragma unroll
    for (int j = 0; j < 8; ++j) { v[j] = xr[64 * j]; s += (v[j].x * v[j].x + v[j].y * v[j].y) + (v[j].z * v[j].z + v[j].w * v[j].w); }
    const float rstd = 1.0f / sqrtf(wave_sum(s) * (1.0f / D) + EPS);
    u32x2* o8 = (u32x2*)orow + lane;
#pragma unroll
    for (int j = 0; j < 8; ++j) {
        const int c = 256 * j + 4 * lane;
        const f32x4 g = *(const f32x4*)(gain + c);
        const f32x4 sc = *(const LAS f32x4*)(scl + c);
        const f32x4 sh = *(const LAS f32x4*)(shl + c);
        const f32x4 y = (v[j] * rstd * g) * (sc + 1.0f) + sh;
        u32x2 w; w.x = pk2(y.x, y.y); w.y = pk2(y.z, y.w); o8[64 * j] = w;
    }
}

__device__ __forceinline__ unsigned fkey(float f) { const unsigned u = __builtin_bit_cast(unsigned, f); return (u & 0x80000000u) ? ~u : (u | 0x80000000u); }
__device__ __forceinline__ float fkey_inv(unsigned k) { const unsigned u = (k & 0x80000000u) ? (k & 0x7fffffffu) : ~k; return __builtin_bit_cast(float, u); }
__device__ __forceinline__ unsigned long long wave_max_u64(unsigned long long v) {
#pragma unroll
    for (int o = 1; o < 64; o <<= 1) { const unsigned long long t = __shfl_xor(v, o); v = t > v ? t : v; }
    return v;
}
__device__ __forceinline__ float gelu_tanh(float x) { const float t = 0.7978845608028654f * (x + 0.044715f * x * x * x); return 0.5f * x * (1.0f + tanhf(t)); }

__global__ void __launch_bounds__(512, 2) mk_fwd(Args a) {
    extern __shared__ __attribute__((aligned(16))) unsigned char lds_raw[];
    LAS unsigned char* lds = (LAS unsigned char*)lds_raw;
    const int tid = threadIdx.x, lane = tid & 63, wave = __builtin_amdgcn_readfirstlane(tid >> 6);
    const int G = gridDim.x, gw = blockIdx.x * 8 + wave, NGW = G * 8;
    unsigned char* ws = a.ws; unsigned char* dob = (unsigned char*)a.out;
    long long* modacc = (long long*)(ws + WS_CTL);
    bf16_t* WoutT = (bf16_t*)(ws + WS_WOUT); bf16_t* WqsT = (bf16_t*)(ws + WS_WQS); bf16_t* WinT = (bf16_t*)(ws + WS_WIN);
    bf16_t* pooled = (bf16_t*)(ws + WS_POOLED); bf16_t* upool = (bf16_t*)(ws + WS_UPOOL); bf16_t* merged = (bf16_t*)(ws + WS_MERGED);
    bf16_t* qb = (bf16_t*)(ws + WS_Q); bf16_t* kb = (bf16_t*)(ws + WS_K); bf16_t* vb = (bf16_t*)(ws + WS_V);
    bf16_t* utab = (bf16_t*)(ws + WS_UTAB); bf16_t* vtab = (bf16_t*)(ws + WS_VTAB);
    float* scores = (float*)(ws + WS_SCORES);
    bf16_t* gret = (bf16_t*)(ws + WS_GRET); bf16_t* fn = (bf16_t*)(ws + WS_FN);
    bf16_t* sap = (bf16_t*)(ws + WS_SAP); bf16_t* sar = (bf16_t*)(ws + WS_SAR);
    bf16_t* hn = (bf16_t*)(dob + DO_HN); float* rcos = (float*)(dob + DO_RCOS); float* rsin = (float*)(dob + DO_RSIN);
    bf16_t* WpcT = (bf16_t*)(dob + DO_WPC); bf16_t* PretT = (bf16_t*)(dob + DO_PRET);
    const int lo = a.ph_lo, hi = a.ph_hi;
#define IN(k) (lo <= (k) && (k) < hi)
#define SEAM(k) do { if (lo <= (k) && (k) + 1 < hi) cg::this_grid().sync(); } while (0)

    if (IN(0)) {
        LAS float* scr = (LAS float*)(lds + wave * 16384);
        constexpr int I_IN = (D / 64) * (NIN / 32), I_PR = (VW / 64) * (D / 32), I_WO = (D / 64) * (D / 32);
        for (int it = gw; it < I_IN + I_PR + I_WO; it += NGW) {
            int r = it;
            if (r < I_IN) { transpose_item(a.w_in, D, NIN, WinT, scr, r, lane); continue; } r -= I_IN;
            if (r < I_PR) { transpose_item(a.w_branch_ret, VW, D, PretT, scr, r, lane); continue; } r -= I_PR;
            transpose_item(a.w_out, D, D, WoutT, scr, r, lane);
        }
        for (int it = gw; it < 4096; it += NGW) {
            const int g = it >> 10, cb = (it >> 5) & 31, nb = it & 31, c0 = cb * 16, n = nb * 64 + lane;
            float acc[16];
#pragma unroll
            for (int i = 0; i < 16; ++i) acc[i] = 0.f;
            const float* pw = a.pool_w + ((size_t)g * 512 + c0) * 512;
            for (int d = 0; d < 512; d += 4) {
                float pv[4];
#pragma unroll
                for (int e = 0; e < 4; ++e) pv[e] = a.pool_scale[g * 512 + d + e] * a.w_branch_pool[(size_t)(g * 512 + d + e) * D + n];
#pragma unroll
                for (int i = 0; i < 16; ++i) { const f32x4 w4 = *(const f32x4*)(pw + (size_t)i * 512 + d); acc[i] += w4.x * pv[0] + w4.y * pv[1] + w4.z * pv[2] + w4.w * pv[3]; }
            }
            u32x4 o0, o1;
            o0.x = pk2(acc[0], acc[1]); o0.y = pk2(acc[2], acc[3]); o0.z = pk2(acc[4], acc[5]); o0.w = pk2(acc[6], acc[7]);
            o1.x = pk2(acc[8], acc[9]); o1.y = pk2(acc[10], acc[11]); o1.z = pk2(acc[12], acc[13]); o1.w = pk2(acc[14], acc[15]);
            bf16_t* dst = WpcT + (size_t)n * D + g * 512 + c0;
            *(u32x4*)dst = o0; *(u32x4*)(dst + 8) = o1;
        }
        for (int it = gw; it < 4096; it += NGW) {
            const int hp = it >> 8, nb = (it >> 5) & 7, db = it & 31, n0 = nb * 16, d = db * 64 + lane;
            float acc[16];
#pragma unroll
            for (int i = 0; i < 16; ++i) acc[i] = 0.f;
            const float* wq = a.peer_w_query + (size_t)d * D + hp * 128;
            const float* sk = a.peer_sub_keys + ((size_t)hp * 128 + n0) * 128;
            for (int c = 0; c < 128; c += 4) {
                const f32x4 q4 = *(const f32x4*)(wq + c);
#pragma unroll
                for (int i = 0; i < 16; ++i) { const f32x4 k4 = *(const f32x4*)(sk + (size_t)i * 128 + c); acc[i] += q4.x * k4.x + q4.y * k4.y + q4.z * k4.z + q4.w * k4.w; }
            }
#pragma unroll
            for (int i = 0; i < 16; ++i) WqsT[(size_t)(hp * 128 + n0 + i) * D + d] = (bf16_t)f2bf(acc[i]);
        }
        for (int idx = blockIdx.x * 512 + tid; idx < S * 128; idx += G * 512) {
            const int t = idx >> 7, i = idx & 127;
            const float inv = (float)pow(10000.0, -(double)(2 * i) / 256.0);
            const float ang = (float)a.positions[t] * inv;
            float sn, cs; sincosf(ang, &sn, &cs);
            rcos[idx] = cs; rsin[idx] = sn;
        }
        for (int it = gw; it < 64 * 48; it += NGW) {
            const int kc = it / 48, nc = it % 48, k0 = kc * 32, n = nc * 256 + lane * 4;
            f32x4 acc = (f32x4){0.f, 0.f, 0.f, 0.f};
#pragma unroll 8
            for (int kk = 0; kk < 32; ++kk) { const float cv = a.c[k0 + kk]; const float sv = cv * sigmoidf_(cv); acc += *(const f32x4*)(a.w_ada + (size_t)(k0 + kk) * (6 * D) + n) * sv; }
#pragma unroll
            for (int e = 0; e < 4; ++e) atomicAdd((unsigned long long*)(modacc + n + e), (unsigned long long)(long long)__double2ll_rn((double)acc[e] * MOD_FX));
        }
    }
    SEAM(0);
    if (IN(1)) {
        LAS float* ml = (LAS float*)lds;
        for (int i = tid; i < 2 * D; i += 512) ml[i] = modval(modacc, a.b_ada, i);
        __syncthreads();
        for (int m = gw; m < S; m += NGW) norm_mod_row(a.x + (size_t)m * D, a.norm_mix_gain, ml, ml + D, hn + (size_t)m * D, lane);
    }
    SEAM(1);
    if (IN(2)) {
        pg8::Gemm g{hn, WinT, S, NIN, D}; pg8::StaticOrder so; so.init(S, NIN, G, (int)blockIdx.x);
        EpiG1 E{upool, qb, kb, vb, gret, sap, sar, rcos, rsin};
        pg8::gemm_phase<EpiG1>(lds, g, so, E);
    }
    SEAM(2);
    if (IN(3)) {
        if (gw < 512) {
            const int h = gw >> 6, u = gw & 63;
            const float gamma = 1.0f - exp2f(-5.0f - (float)h);
            float st[4][8];
#pragma unroll
            for (int e = 0; e < 4; ++e)
#pragma unroll
                for (int c = 0; c < 8; ++c) st[e][c] = 0.f;
            const bf16_t* qp = qb + h * 256 + 4 * lane; const bf16_t* kp = kb + h * 256 + 4 * lane; bf16_t* vp = vb + h * 512 + 8 * u;
            for (int t0 = 0; t0 < S; t0 += 8) {
                u32x2 qv[8], kv[8]; u32x4 vv[8];
#pragma unroll
                for (int i = 0; i < 8; ++i) { qv[i] = *(const u32x2*)(qp + (size_t)(t0 + i) * 2048); kv[i] = *(const u32x2*)(kp + (size_t)(t0 + i) * 2048); vv[i] = *(const u32x4*)(vp + (size_t)(t0 + i) * 4096); }
#pragma unroll
                for (int i = 0; i < 8; ++i) {
                    const float q4[4] = {bf_lo(qv[i].x), bf_hi(qv[i].x), bf_lo(qv[i].y), bf_hi(qv[i].y)};
                    const float k4[4] = {bf_lo(kv[i].x), bf_hi(kv[i].x), bf_lo(kv[i].y), bf_hi(kv[i].y)};
                    const float v8[8] = {bf_lo(vv[i].x), bf_hi(vv[i].x), bf_lo(vv[i].y), bf_hi(vv[i].y), bf_lo(vv[i].z), bf_hi(vv[i].z), bf_lo(vv[i].w), bf_hi(vv[i].w)};
                    float d[8];
#pragma unroll
                    for (int c = 0; c < 8; ++c) {
                        float acc = 0.f;
#pragma unroll
                        for (int e = 0; e < 4; ++e) { st[e][c] = st[e][c] * gamma + k4[e] * v8[c]; acc += q4[e] * st[e][c]; }
                        d[c] = acc;
                    }
                    float k1[4], k2[2], k3;
                    const bool b5 = lane & 32, b4 = lane & 16, b3 = lane & 8;
#pragma unroll
                    for (int c = 0; c < 4; ++c) { const float snd = b5 ? d[c] : d[c + 4]; const float rcv = __shfl_xor(snd, 32); k1[c] = (b5 ? d[c + 4] : d[c]) + rcv; }
#pragma unroll
                    for (int c = 0; c < 2; ++c) { const float snd = b4 ? k1[c] : k1[c + 2]; const float rcv = __shfl_xor(snd, 16); k2[c] = (b4 ? k1[c + 2] : k1[c]) + rcv; }
                    { const float snd = b3 ? k2[0] : k2[1]; const float rcv = __shfl_xor(snd, 8); k3 = (b3 ? k2[1] : k2[0]) + rcv; }
                    k3 += __shfl_xor(k3, 4); k3 += __shfl_xor(k3, 2); k3 += __shfl_xor(k3, 1);
                    if ((lane & 7) == 0) { const int col = (b5 ? 4 : 0) + (b4 ? 2 : 0) + (b3 ? 1 : 0); vp[(size_t)(t0 + i) * 4096 + col] = (bf16_t)f2bf(k3); }
                }
            }
        }
        for (int idx = blockIdx.x * 512 + tid; idx < S * 256; idx += G * 512) {
            const int t = idx >> 8, c8 = (idx & 255) * 8, grp = c8 >> 9, w = 2 << grp;
            const int cnt = (t + 1 < w) ? (t + 1) : w;
            float sum[8];
#pragma unroll
            for (int e = 0; e < 8; ++e) sum[e] = 0.f;
            u32x4 cur = (u32x4){0u, 0u, 0u, 0u};
            for (int j = 0; j < cnt; ++j) {
                const u32x4 uv = *(const u32x4*)(upool + (size_t)(t - j) * 2048 + c8);
                if (j == 0) cur = uv;
                sum[0] += bf_lo(uv.x); sum[1] += bf_hi(uv.x); sum[2] += bf_lo(uv.y); sum[3] += bf_hi(uv.y);
                sum[4] += bf_lo(uv.z); sum[5] += bf_hi(uv.z); sum[6] += bf_lo(uv.w); sum[7] += bf_hi(uv.w);
            }
            const float inv = 1.0f / (float)cnt;
            u32x4 o;
            o.x = pk2(sum[0] * inv - bf_lo(cur.x), sum[1] * inv - bf_hi(cur.x)); o.y = pk2(sum[2] * inv - bf_lo(cur.y), sum[3] * inv - bf_hi(cur.y));
            o.z = pk2(sum[4] * inv - bf_lo(cur.z), sum[5] * inv - bf_hi(cur.z)); o.w = pk2(sum[6] * inv - bf_lo(cur.w), sum[7] * inv - bf_hi(cur.w));
            *(u32x4*)(pooled + (size_t)t * 2048 + c8) = o;
        }
    }
    SEAM(3);
    if (IN(4)) {
        for (int un = gw; un < S * RH; un += NGW) {
            const int t = un >> 3, h = un & 7;
            bf16_t* yp = vb + (size_t)t * 4096 + h * 512 + 8 * lane;
            const u32x4 yv = *(const u32x4*)yp;
            float y[8] = {bf_lo(yv.x), bf_hi(yv.x), bf_lo(yv.y), bf_hi(yv.y), bf_lo(yv.z), bf_hi(yv.z), bf_lo(yv.w), bf_hi(yv.w)};
            float s = 0.f;
#pragma unroll
            for (int e = 0; e < 8; ++e) s += y[e];
            const float mean = wave_sum(s) * (1.0f / 512.0f);
            float s2 = 0.f;
#pragma unroll
            for (int e = 0; e < 8; ++e) { y[e] -= mean; s2 += y[e] * y[e]; }
            const float rstd = 1.0f / sqrtf(wave_sum(s2) * (1.0f / 512.0f) + EPS);
            const u32x4 gv = *(const u32x4*)(gret + (size_t)t * 4096 + h * 512 + 8 * lane);
            const float gg[8] = {bf_lo(gv.x), bf_hi(gv.x), bf_lo(gv.y), bf_hi(gv.y), bf_lo(gv.z), bf_hi(gv.z), bf_lo(gv.w), bf_hi(gv.w)};
            const f32x4 n0 = *(const f32x4*)(a.ret_norm_gain + h * 512 + 8 * lane), n1 = *(const f32x4*)(a.ret_norm_gain + h * 512 + 8 * lane + 4);
            const float nn[8] = {n0.x, n0.y, n0.z, n0.w, n1.x, n1.y, n1.z, n1.w};
            float o[8];
#pragma unroll
            for (int e = 0; e < 8; ++e) o[e] = y[e] * rstd * nn[e] * gg[e];
            u32x4 w; w.x = pk2(o[0], o[1]); w.y = pk2(o[2], o[3]); w.z = pk2(o[4], o[5]); w.w = pk2(o[6], o[7]);
            *(u32x4*)yp = w;
        }
    }
    SEAM(4);
    if (IN(5)) {
        { pg8::Gemm g{pooled, WpcT, S, D, D}; pg8::StaticOrder so; so.init(S, D, G, (int)blockIdx.x);
          EpiGate<0> E{sap, merged}; pg8::gemm_phase<EpiGate<0>>(lds, g, so, E); }
        { pg8::Gemm g{vb, PretT, S, D, VW}; pg8::StaticOrder so; so.init(S, D, G, (int)blockIdx.x);
          EpiGate<1> E{sar, merged}; pg8::gemm_phase<EpiGate<1>>(lds, g, so, E); }
    }
    SEAM(5);
    if (IN(6)) {
        pg8::Gemm g{merged, WoutT, S, D, D}; pg8::StaticOrder so; so.init(S, D, G, (int)blockIdx.x);
        EpiRes E{a.x, a.out, modacc, a.b_ada}; pg8::gemm_phase<EpiRes>(lds, g, so, E);
    }
    SEAM(6);
    if (IN(7)) {
        LAS float* ml = (LAS float*)lds;
        for (int i = tid; i < 2 * D; i += 512) ml[i] = modval(modacc, a.b_ada, 3 * D + i);
        __syncthreads();
        for (int m = gw; m < S; m += NGW) norm_mod_row(a.out + (size_t)m * D, a.norm_ffn_gain, ml, ml + D, fn + (size_t)m * D, lane);
        for (size_t i4 = (size_t)blockIdx.x * 512 + tid; i4 < (size_t)NE * D / 4; i4 += (size_t)G * 512) {
            const f32x4 uv = ((const f32x4*)a.peer_u)[i4], vv = ((const f32x4*)a.peer_v)[i4];
            u32x2 w; w.x = pk2(uv.x, uv.y); w.y = pk2(uv.z, uv.w); ((u32x2*)utab)[i4] = w;
            w.x = pk2(vv.x, vv.y); w.y = pk2(vv.z, vv.w); ((u32x2*)vtab)[i4] = w;
        }
    }
    SEAM(7);
    if (IN(8)) {
        pg8::Gemm g{fn, WqsT, S, D, D}; pg8::StaticOrder so; so.init(S, D, G, (int)blockIdx.x);
        EpiF32 E{scores}; pg8::gemm_phase<EpiF32>(lds, g, so, E);
    }
    SEAM(8);
    if (IN(9)) {
        LAS int* wex = (LAS int*)(lds + wave * 2048);
        LAS float* wgt = (LAS float*)(lds + wave * 2048 + 512);
        LAS float* g2l = (LAS float*)(lds + 32768);
        for (int i = tid; i < D; i += 512) g2l[i] = modval(modacc, a.b_ada, 5 * D + i);
        __syncthreads();
        for (int t = gw; t < S; t += NGW) {
            const float* srow = scores + (size_t)t * 2048;
            for (int h = 0; h < 8; ++h) {
                float tv[2]; int ti[2];
#pragma unroll
                for (int p = 0; p < 2; ++p) {
                    const float* sp = srow + h * 256 + p * 128;
                    unsigned long long k0 = ((unsigned long long)fkey(sp[lane]) << 32) | (unsigned)(0xffffffffu - (unsigned)lane);
                    unsigned long long k1 = ((unsigned long long)fkey(sp[lane + 64]) << 32) | (unsigned)(0xffffffffu - (unsigned)(lane + 64));
                    float tvv = 0.f; int tii = 0;
                    for (int r = 0; r < 16; ++r) {
                        const unsigned long long best = wave_max_u64(k0 > k1 ? k0 : k1);
                        const int bi = (int)(0xffffffffu - (unsigned)(best & 0xffffffffu));
                        if (bi == lane) k0 = 0ull; if (bi == lane + 64) k1 = 0ull;
                        if (lane == r) { tvv = fkey_inv((unsigned)(best >> 32)); tii = bi; }
                    }
                    tv[p] = tvv; ti[p] = tii;
                }
                unsigned long long ck[4];
#pragma unroll
                for (int e = 0; e < 4; ++e) {
                    const int ci = 4 * lane + e;
                    const float sv = __shfl(tv[0], ci >> 4) + __shfl(tv[1], ci & 15);
                    ck[e] = ((unsigned long long)fkey(sv) << 32) | (unsigned)(0xffffffffu - (unsigned)ci);
                }
                float bs = 0.f; int bci = 0;
                for (int r = 0; r < 16; ++r) {
                    unsigned long long m01 = ck[0] > ck[1] ? ck[0] : ck[1], m23 = ck[2] > ck[3] ? ck[2] : ck[3];
                    const unsigned long long best = wave_max_u64(m01 > m23 ? m01 : m23);
                    const int bi = (int)(0xffffffffu - (unsigned)(best & 0xffffffffu));
#pragma unroll
                    for (int e = 0; e < 4; ++e) if (bi == 4 * lane + e) ck[e] = 0ull;
                    if (lane == r) { bs = fkey_inv((unsigned)(best >> 32)); bci = bi; }
                }
                const int ea = __shfl(ti[0], bci >> 4), eb = __shfl(ti[1], bci & 15);
                const float mx = __shfl(bs, 0);
                float ex = (lane < 16) ? __expf(bs - mx) : 0.f;
                const float den = wave_sum(ex);
                if (lane < 16) { wex[h * 16 + lane] = ea * 128 + eb; wgt[h * 16 + lane] = ex / den; }
            }
            LDS_WAIT();
            float xr[4][8];
#pragma unroll
            for (int j = 0; j < 4; ++j) { const u32x4 w = *(const u32x4*)(fn + (size_t)t * 2048 + 512 * j + 8 * lane);
                xr[j][0] = bf_lo(w.x); xr[j][1] = bf_hi(w.x); xr[j][2] = bf_lo(w.y); xr[j][3] = bf_hi(w.y); xr[j][4] = bf_lo(w.z); xr[j][5] = bf_hi(w.z); xr[j][6] = bf_lo(w.w); xr[j][7] = bf_hi(w.w); }
#pragma unroll 4
            for (int kk = 0; kk < 128; ++kk) {
                const int e = __builtin_amdgcn_readfirstlane(wex[kk]);
                const bf16_t* up = utab + (size_t)e * 2048 + 8 * lane;
                float dsum = 0.f;
#pragma unroll
                for (int j = 0; j < 4; ++j) { const u32x4 w = *(const u32x4*)(up + 512 * j);
                    dsum += xr[j][0] * bf_lo(w.x) + xr[j][1] * bf_hi(w.x) + xr[j][2] * bf_lo(w.y) + xr[j][3] * bf_hi(w.y) + xr[j][4] * bf_lo(w.z) + xr[j][5] * bf_hi(w.z) + xr[j][6] * bf_lo(w.w) + xr[j][7] * bf_hi(w.w); }
                dsum = wave_sum(dsum);
                if (lane == 0) wgt[kk] = wgt[kk] * gelu_tanh(dsum);
            }
            LDS_WAIT();
            float oa[4][8];
#pragma unroll
            for (int j = 0; j < 4; ++j)
#pragma unroll
                for (int e = 0; e < 8; ++e) oa[j][e] = 0.f;
#pragma unroll 4
            for (int kk = 0; kk < 128; ++kk) {
                const int e = __builtin_amdgcn_readfirstlane(wex[kk]);
                const float cf = wgt[kk];
                const bf16_t* vp2 = vtab + (size_t)e * 2048 + 8 * lane;
#pragma unroll
                for (int j = 0; j < 4; ++j) { const u32x4 w = *(const u32x4*)(vp2 + 512 * j);
                    oa[j][0] += cf * bf_lo(w.x); oa[j][1] += cf * bf_hi(w.x); oa[j][2] += cf * bf_lo(w.y); oa[j][3] += cf * bf_hi(w.y);
                    oa[j][4] += cf * bf_lo(w.z); oa[j][5] += cf * bf_hi(w.z); oa[j][6] += cf * bf_lo(w.w); oa[j][7] += cf * bf_hi(w.w); }
            }
            float* orow = a.out + (size_t)t * 2048;
            float ss = 0.f;
#pragma unroll
            for (int j = 0; j < 4; ++j)
#pragma unroll
                for (int hh = 0; hh < 2; ++hh) {
                    const int c = 512 * j + 8 * lane + 4 * hh;
                    const f32x4 x1 = *(const f32x4*)(orow + c);
                    const f32x4 g2 = *(const LAS f32x4*)(g2l + c);
#pragma unroll
                    for (int e = 0; e < 4; ++e) { const float v2 = x1[e] + g2[e] * oa[j][4 * hh + e]; oa[j][4 * hh + e] = v2; ss += v2 * v2; }
                }
            const float rstd = 1.0f / sqrtf(wave_sum(ss) * (1.0f / D) + EPS);
#pragma unroll
            for (int j = 0; j < 4; ++j)
#pragma unroll
                for (int hh = 0; hh < 2; ++hh) {
                    const int c = 512 * j + 8 * lane + 4 * hh;
                    const f32x4 fg = *(const f32x4*)(a.final_norm_gain + c);
                    f32x4 o; o.x = oa[j][4 * hh] * rstd * fg.x; o.y = oa[j][4 * hh + 1] * rstd * fg.y; o.z = oa[j][4 * hh + 2] * rstd * fg.z; o.w = oa[j][4 * hh + 3] * rstd * fg.w;
                    *(f32x4*)(orow + c) = o;
                }
            LDS_WAIT();
        }
    }
#undef IN
#undef SEAM
}

extern "C" void kernel_launch(void* const* d_in, const int* in_sizes, int n_in, void* d_out, int out_size, void* d_ws, size_t ws_size, hipStream_t stream) {
    static int grid = 0;
    if (grid == 0) {
        if (n_in != 19 || out_size != S * D || ws_size < WS_END) { fprintf(stderr, "kernel_launch: unexpected problem (n_in %d out %d ws %zu)\n", n_in, out_size, ws_size); grid = -1; return; }
        int dev = 0, cus = 0, per_cu = 0;
        hipGetDevice(&dev); hipDeviceGetAttribute(&cus, hipDeviceAttributeMultiprocessorCount, dev);
        hipFuncSetAttribute((const void*)mk_fwd, hipFuncAttributeMaxDynamicSharedMemorySize, LDS_BYTES);
        hipOccupancyMaxActiveBlocksPerMultiprocessor(&per_cu, (const void*)mk_fwd, 512, LDS_BYTES);
        (void)hipGetLastError();
        if (per_cu < 1) { fprintf(stderr, "kernel_launch: occupancy query says %d blocks per CU\n", per_cu); per_cu = 1; }
        grid = cus * 1;
    }
    if (grid < 0) return;
    hipMemsetAsync((char*)d_ws + WS_CTL, 0, 1 * MiB, stream);
    Args a{};
    a.x = (const float*)d_in[0]; a.c = (const float*)d_in[1]; a.positions = (const int*)d_in[2]; a.norm_mix_gain = (const float*)d_in[3];
    a.w_ada = (const float*)d_in[4]; a.b_ada = (const float*)d_in[5]; a.w_in = (const float*)d_in[6]; a.pool_w = (const float*)d_in[7];
    a.pool_scale = (const float*)d_in[8]; a.ret_norm_gain = (const float*)d_in[9]; a.w_branch_pool = (const float*)d_in[10]; a.w_branch_ret = (const float*)d_in[11];
    a.w_out = (const float*)d_in[12]; a.norm_ffn_gain = (const float*)d_in[13]; a.peer_w_query = (const float*)d_in[14]; a.peer_sub_keys = (const float*)d_in[15];
    a.peer_u = (const float*)d_in[16]; a.peer_v = (const float*)d_in[17]; a.final_norm_gain = (const float*)d_in[18];
    a.out = (float*)d_out; a.ws = (unsigned char*)d_ws;
#if MK_N_LAUNCHES == 1
    a.ph_lo = 0; a.ph_hi = NPHASE;
    void* args[] = {&a};
    hipError_t e = hipLaunchCooperativeKernel((const void*)mk_fwd, dim3(grid), dim3(512), args, LDS_BYTES, stream);
    if (e != hipSuccess) fprintf(stderr, "cooperative launch failed: %s (grid %d)\n", hipGetErrorString(e), grid);
#else
    for (int p = 0; p < NPHASE; ++p) { a.ph_lo = p; a.ph_hi = p + 1; hipLaunchKernelGGL(mk_fwd, dim3(grid), dim3(512), LDS_BYTES, stream, a); }
#endif
}
```

```cpp
#include <hip/hip_runtime.h>
#include <hip/hip_cooperative_groups.h>
#include <cstdio>
#include <cstdint>
namespace cg = cooperative_groups;

#ifndef PEER_UMFMA
#define PEER_UMFMA 1
#endif
#ifndef PEER_UFP4
#define PEER_UFP4 1
#endif
#ifndef PEER_VFP4
#define PEER_VFP4 1
#endif
#ifndef PEER_DEPTH3
#define PEER_DEPTH3 0
#endif
#ifndef PEER_F16
#define PEER_F16 1
#endif
#ifndef MK_N_LAUNCHES
#define MK_N_LAUNCHES 1
#endif

#define LAS __attribute__((address_space(3)))
typedef unsigned short bf16_t;
typedef short bf16x8 __attribute__((ext_vector_type(8)));
typedef float f32x4 __attribute__((ext_vector_type(4)));
typedef float f32x2 __attribute__((ext_vector_type(2)));
typedef unsigned u32x4 __attribute__((ext_vector_type(4)));
typedef unsigned u32x2 __attribute__((ext_vector_type(2)));
typedef unsigned u32x6 __attribute__((ext_vector_type(6)));
typedef float f32x32 __attribute__((ext_vector_type(32)));
typedef _Float16 h16x2 __attribute__((ext_vector_type(2)));
typedef _Float16 h16x32 __attribute__((ext_vector_type(32)));

constexpr int NB16 = 2048;
constexpr int S = 16384, D = 2048, NIN = 18432, RH = 8, DK = 256, DV = 512, VW = 4096, NE = 16384;
constexpr float EPS = 1e-6f;
constexpr int NPHASE = 11;

constexpr size_t MiB = 1u << 20;
constexpr size_t WS_CTL = 0;
constexpr size_t CTL_SCALE = 100 * 1024, CTL_BAR = 104 * 1024, CTL_ZERO_BYTES = 128 * 1024;
constexpr size_t WS_WOUT = 1 * MiB;
constexpr size_t WS_WQS = 9 * MiB;
constexpr size_t WS_WIN = 17 * MiB;
constexpr size_t WS_POOLED = WS_WIN;
constexpr size_t WS_UPOOL = 89 * MiB;
constexpr size_t WS_MERGED = WS_UPOOL;
constexpr size_t WS_Q = 153 * MiB;
constexpr size_t WS_K = 217 * MiB;
#define TAB_IN_RET (PEER_UFP4 && PEER_VFP4)
#if TAB_IN_RET
constexpr size_t WS_UTAB = 665 * MiB;
constexpr size_t WS_VTAB = 681 * MiB;
#else
constexpr size_t WS_UTAB = WS_Q;
constexpr size_t WS_VTAB = WS_Q + 32 * MiB;
#endif
constexpr size_t WS_V = 281 * MiB;
constexpr size_t WS_SCORES = WS_V;
constexpr size_t WS_GRET = 409 * MiB;
constexpr size_t WS_FN = WS_GRET;
constexpr size_t WS_HN8 = 473 * MiB;
constexpr size_t WS_SAP = 537 * MiB;
constexpr size_t WS_SAR = 601 * MiB;
constexpr size_t WS_END = (TAB_IN_RET ? 697 : 665) * MiB;
constexpr size_t DO_HN = 0;
constexpr size_t DO_RCOS = 64 * MiB;
constexpr size_t DO_RSIN = 72 * MiB;
constexpr size_t DO_WPC = 80 * MiB;
constexpr size_t DO_PRET = 88 * MiB;

constexpr int LDS_BYTES = 147456;

__device__ __forceinline__ unsigned f2bf(float f) { unsigned u = __builtin_bit_cast(unsigned, f); return (u + 0x7fffu + ((u >> 16) & 1u)) >> 16; }
typedef __bf16 bf16n2 __attribute__((ext_vector_type(2)));
__device__ __forceinline__ unsigned pk2(float lo, float hi) { const f32x2 v = {lo, hi}; return __builtin_bit_cast(unsigned, __builtin_convertvector(v, bf16n2)); }
__device__ __forceinline__ float bf_lo(unsigned u) { return __builtin_bit_cast(float, u << 16); }
__device__ __forceinline__ float bf_hi(unsigned u) { return __builtin_bit_cast(float, u & 0xffff0000u); }
__device__ __forceinline__ float wave_sum(float v) {
#pragma unroll
    for (int o = 1; o < 64; o <<= 1) v += __shfl_xor(v, o);
    return v;
}
#define LDS_WAIT() asm volatile("s_waitcnt lgkmcnt(0)" ::: "memory")
constexpr double MOD_FX = 1099511627776.0;
__device__ __forceinline__ int lane_id() { int r; asm volatile("v_mbcnt_lo_u32_b32 %0, -1, 0\n\tv_mbcnt_hi_u32_b32 %0, -1, %0" : "=v"(r)); return r; }
__device__ __forceinline__ int launder(int x) { asm volatile("" : "+v"(x)); return x; }
__device__ __forceinline__ float modval(const long long* macc, const float* b_ada, int i) { return (float)((double)macc[i] * (1.0 / MOD_FX)) + b_ada[i]; }

namespace pg8 {
constexpr int BM = 256, BK = 64, HALF = 128, HTB = HALF * BK * 2, STAGE_BYTES = 8 * HTB, NXCD = 8, WGM = 8;
__host__ __device__ __forceinline__ int lds_byte(int r, int c) { const int st = (r >> 4) * 2 + (c >> 5), rr = r & 15, cc = c & 31, ob = rr * 64 + cc * 2; return st * 1024 + (ob ^ (((ob >> 9) & 1) << 5)); }
__host__ __device__ __forceinline__ void stage_rc(int b, int& R, int& C) { const int st = b / 1024, sb = b % 1024, swz = sb ^ (((sb >> 9) & 1) << 5); R = (st >> 1) * 16 + swz / 64; C = (st & 1) * 32 + (swz % 64) / 2; }
__host__ __device__ __forceinline__ int perm32(int rho) { const int n = rho >> 4, i = rho & 15; return 8 * (i >> 2) + 4 * n + (i & 3); }
struct Unit { int pm, pn; };
struct Gemm { const bf16_t* A; const bf16_t* Bt; int M, N, K; };
struct StaticOrder {
    int nM, nN, nwg, G, c;
    __host__ __device__ void init(int M, int N, int G_, int c_) { nM = M / BM; nN = N / BM; nwg = nM * nN; G = G_; c = c_; }
    __host__ __device__ bool next(int i, Unit& u) const {
        const long L = (long)i * G + c; if (L >= nwg) return false;
        int wgid = (int)L; { const int q = nwg / NXCD, r = nwg % NXCD, xcd = wgid % NXCD, off = wgid / NXCD; wgid = (xcd < r ? xcd * (q + 1) : r * (q + 1) + (xcd - r) * q) + off; }
        const int nig = WGM * nN, gid = wgid / nig, fm = gid * WGM, gsz = (nM - fm) < WGM ? (nM - fm) : WGM;
        u.pm = fm + ((wgid % nig) % gsz); u.pn = (wgid % nig) / gsz; return true;
    }
};
typedef int i32x4_t __attribute__((ext_vector_type(4)));
typedef int i32x8_t __attribute__((ext_vector_type(8)));
__device__ __forceinline__ i32x8_t cat8(const bf16x8& lo, const bf16x8& hi) { return __builtin_shufflevector(__builtin_bit_cast(i32x4_t, lo), __builtin_bit_cast(i32x4_t, hi), 0, 1, 2, 3, 4, 5, 6, 7); }
__device__ __forceinline__ void mfma_fp8(f32x4& c, const i32x8_t& a, const i32x8_t& b, int sa, int sb) {
    asm volatile("v_mfma_scale_f32_16x16x128_f8f6f4 %0, %1, %2, %0, %3, %4 op_sel_hi:[0,0,0]" : "+v"(c) : "v"(a), "v"(b), "v"(sa), "v"(sb));
}
template <class Epi, bool ALIGN_EPI = true, bool SP2 = true, bool FP8 = false>
__device__ __forceinline__ void gemm_phase(LAS unsigned char* lds, const Gemm g, const StaticOrder& S, const Epi& E, int wid) {
    const int lane = launder(lane_id()), tid = wid * 64 + lane, wr = wid >> 2, wc = wid & 3, fr = lane & 15, fq = lane >> 4;
    constexpr int EB = FP8 ? 1 : 2;
    const int K = g.K, nt = K * EB / (BK * 2);
    unsigned voffA[2], voffB[2];
#pragma unroll
    for (int i = 0; i < 2; ++i) { int R, C; stage_rc(tid * 16 + i * 8192, R, C); const int Rb = Epi::PERM ? ((R & ~31) + perm32(R & 31)) : R;
        voffA[i] = (unsigned)(R * K * EB + C * 2); voffB[i] = (unsigned)(Rb * K * EB + C * 2); }
    const size_t kstep = (size_t)(BK * 2);
    const size_t hstep = (size_t)HALF * K * EB;
    const size_t tstep = 2 * hstep;
    const unsigned ldsw = (unsigned)wid * 1024u;
    const int aoff = lds_byte(wr * 64 + fr, fq * 8), boff = lds_byte(wc * 32 + fr, fq * 8);
#define PG8_SA(b, h) (((b) * 2 + (h)) * HTB)
#define PG8_SB(b, h) ((4 + (b) * 2 + (h)) * HTB)
#define PG8_STAGE(bufoff, gbase, voff) do { _Pragma("unroll") for (int _i = 0; _i < 2; ++_i) \
        __builtin_amdgcn_global_load_lds((const unsigned*)((const char*)(gbase) + (voff)[_i]), (LAS unsigned*)(lds + (bufoff) + ldsw + _i * 8192), 16, 0, 0); } while (0)
#define PG8_LDA(dst, b, h) do { _Pragma("unroll") for (int m = 0; m < 4; ++m) _Pragma("unroll") for (int k = 0; k < 2; ++k) dst[m][k] = *(const LAS bf16x8*)(lds + PG8_SA(b, h) + aoff + m * 2048 + k * 1024); } while (0)
#define PG8_LDB(dst, b, h) do { _Pragma("unroll") for (int n = 0; n < 2; ++n) _Pragma("unroll") for (int k = 0; k < 2; ++k) dst[n][k] = *(const LAS bf16x8*)(lds + PG8_SB(b, h) + boff + n * 2048 + k * 1024); } while (0)
#define PG8_MMA(ai, bj, At, Bt) do { __builtin_amdgcn_s_setprio(1); if constexpr (FP8) asm volatile("s_nop 3"); _Pragma("unroll") for (int m = 0; m < 4; ++m) _Pragma("unroll") for (int n = 0; n < 2; ++n) { \
        if constexpr (FP8) mfma_fp8(acc[ai][bj][m][n], cat8(Bt[n][0], Bt[n][1]), cat8(At[m][0], At[m][1]), sc_w, sc_a); \
        else { _Pragma("unroll") for (int k = 0; k < 2; ++k) acc[ai][bj][m][n] = __builtin_amdgcn_mfma_f32_16x16x32_bf16(Bt[n][k], At[m][k], acc[ai][bj][m][n], 0, 0, 0); } } __builtin_amdgcn_s_setprio(0); } while (0)
#define PG8_WAIT_V(n) asm volatile("s_waitcnt vmcnt(" #n ")" ::: "memory")
#define PG8_WAIT_L(n) asm volatile("s_waitcnt lgkmcnt(" #n ")" ::: "memory")
#define PG8_BAR __builtin_amdgcn_s_barrier()
#define PG8_SCHED __builtin_amdgcn_sched_barrier(0)
    Unit cur, nxt; int ui = 0;
    if (!S.next(0, cur)) return;
    const int sc_w = 0x76767676, sc_a = 0x7C7C7C7C;
    f32x4 acc[2][2][4][2];
#pragma unroll
    for (int a = 0; a < 2; ++a)
#pragma unroll
        for (int b = 0; b < 2; ++b)
#pragma unroll
            for (int m = 0; m < 4; ++m)
#pragma unroll
                for (int n = 0; n < 2; ++n) acc[a][b][m][n] = (f32x4){0.f, 0.f, 0.f, 0.f};
    bf16x8 At[4][2], B0[2][2], B1[2][2];
    const char* cA = (const char*)g.A + (size_t)cur.pm * tstep; const char* cB = (const char*)g.Bt + (size_t)cur.pn * tstep;
    if constexpr (SP2) {
        PG8_STAGE(PG8_SB(0, 0), cB, voffB); PG8_STAGE(PG8_SB(0, 1), cB + hstep, voffB); PG8_STAGE(PG8_SA(0, 0), cA, voffA); PG8_STAGE(PG8_SA(0, 1), cA + hstep, voffA);
        if (wr == 1) PG8_BAR;
        PG8_WAIT_V(2); PG8_BAR;
        PG8_STAGE(PG8_SB(1, 0), cB + kstep, voffB); PG8_STAGE(PG8_SA(1, 0), cA + kstep, voffA); PG8_STAGE(PG8_SB(1, 1), cB + hstep + kstep, voffB);
        PG8_WAIT_V(6); PG8_BAR;
    } else {
        PG8_STAGE(PG8_SB(0, 0), cB, voffB); PG8_STAGE(PG8_SA(0, 0), cA, voffA); PG8_STAGE(PG8_SB(0, 1), cB + hstep, voffB); PG8_STAGE(PG8_SA(0, 1), cA + hstep, voffA);
        if (wr == 1) PG8_BAR;
        PG8_WAIT_V(4); PG8_BAR;
        PG8_STAGE(PG8_SB(1, 0), cB + kstep, voffB); PG8_STAGE(PG8_SA(1, 0), cA + kstep, voffA); PG8_STAGE(PG8_SB(1, 1), cB + hstep + kstep, voffB);
        PG8_WAIT_V(6); PG8_BAR;
    }
    for (;;) {
        const bool has_next = S.next(ui + 1, nxt);
        const char* nA = has_next ? (const char*)g.A + (size_t)nxt.pm * tstep : cA; const char* nB = has_next ? (const char*)g.Bt + (size_t)nxt.pn * tstep : cB;
        for (int t = 0; t < nt; t += 2) {
            const bool last = (t == nt - 2);
            const char* a1 = cA + (size_t)(t + 1) * kstep;
            const char* a2 = last ? nA : cA + (size_t)(t + 2) * kstep; const char* b2 = last ? nB : cB + (size_t)(t + 2) * kstep;
            const char* a3 = a2 + kstep; const char* b3 = b2 + kstep;
            if constexpr (SP2) {
            PG8_LDB(B0, 0, 0); PG8_LDB(B1, 0, 1); PG8_SCHED; PG8_LDA(At, 0, 0); PG8_STAGE(PG8_SA(1, 1), a1 + hstep, voffA);
            PG8_WAIT_V(8); PG8_WAIT_L(0); PG8_BAR; PG8_MMA(0, 0, At, B0); PG8_MMA(0, 1, At, B1); PG8_BAR; PG8_SCHED;
            PG8_LDA(At, 0, 1); PG8_STAGE(PG8_SB(0, 0), b2, voffB); PG8_STAGE(PG8_SB(0, 1), b2 + hstep, voffB); PG8_STAGE(PG8_SA(0, 0), a2, voffA);
            PG8_WAIT_V(8); PG8_WAIT_L(0); PG8_BAR; PG8_MMA(1, 0, At, B0); PG8_MMA(1, 1, At, B1); PG8_BAR; PG8_SCHED;
            PG8_LDB(B0, 1, 0); PG8_LDB(B1, 1, 1); PG8_SCHED; PG8_LDA(At, 1, 0); PG8_STAGE(PG8_SA(0, 1), a2 + hstep, voffA);
            PG8_WAIT_V(8); PG8_WAIT_L(0); PG8_BAR; PG8_MMA(0, 0, At, B0); PG8_MMA(0, 1, At, B1); PG8_BAR; PG8_SCHED;
            PG8_LDA(At, 1, 1); PG8_STAGE(PG8_SB(1, 0), b3, voffB); PG8_STAGE(PG8_SB(1, 1), b3 + hstep, voffB); PG8_STAGE(PG8_SA(1, 0), a3, voffA);
            PG8_WAIT_V(8); PG8_WAIT_L(0); PG8_BAR; PG8_MMA(1, 0, At, B0); PG8_MMA(1, 1, At, B1); PG8_BAR; PG8_SCHED;
            } else {
            PG8_LDB(B0, 0, 0); PG8_SCHED; PG8_LDA(At, 0, 0); PG8_STAGE(PG8_SA(1, 1), a1 + hstep, voffA);
            PG8_WAIT_L(8); PG8_BAR; PG8_WAIT_L(0); PG8_MMA(0, 0, At, B0); PG8_BAR; PG8_SCHED;
            PG8_LDB(B1, 0, 1); PG8_STAGE(PG8_SB(0, 0), b2, voffB);
            PG8_BAR; PG8_WAIT_L(0); PG8_MMA(0, 1, At, B1); PG8_BAR;
            PG8_LDA(At, 0, 1); PG8_STAGE(PG8_SA(0, 0), a2, voffA);
            PG8_BAR; PG8_WAIT_L(0); PG8_MMA(1, 0, At, B0); PG8_BAR; PG8_SCHED;
            PG8_STAGE(PG8_SB(0, 1), b2 + hstep, voffB);
            PG8_WAIT_V(6); PG8_BAR; PG8_MMA(1, 1, At, B1); PG8_BAR;
            PG8_LDB(B0, 1, 0); PG8_SCHED; PG8_LDA(At, 1, 0); PG8_STAGE(PG8_SA(0, 1), a2 + hstep, voffA);
            PG8_WAIT_L(8); PG8_BAR; PG8_WAIT_L(0); PG8_MMA(0, 0, At, B0); PG8_BAR; PG8_SCHED;
            PG8_LDB(B1, 1, 1); PG8_STAGE(PG8_SB(1, 0), b3, voffB);
            PG8_BAR; PG8_WAIT_L(0); PG8_MMA(0, 1, At, B1); PG8_BAR;
            PG8_LDA(At, 1, 1); PG8_STAGE(PG8_SA(1, 0), a3, voffA);
            PG8_BAR; PG8_WAIT_L(0); PG8_MMA(1, 0, At, B0); PG8_BAR; PG8_SCHED;
            PG8_STAGE(PG8_SB(1, 1), b3 + hstep, voffB);
            PG8_WAIT_V(6); PG8_BAR; PG8_MMA(1, 1, At, B1); PG8_BAR;
            }
        }
        if constexpr (ALIGN_EPI) { if (wr == 0) PG8_BAR; }
        if constexpr (FP8) asm volatile("s_nop 15\n\ts_nop 7" ::: "memory");
        if constexpr (FP8) { const int l2 = launder(lane_id()); E(acc, cur, wr, wc, l2 & 15, l2 >> 4); }
        else E(acc, cur, wr, wc, fr, fq);
        if (!has_next) break;
#pragma unroll
        for (int a = 0; a < 2; ++a)
#pragma unroll
            for (int b = 0; b < 2; ++b)
#pragma unroll
                for (int m = 0; m < 4; ++m)
#pragma unroll
                    for (int n = 0; n < 2; ++n) acc[a][b][m][n] = (f32x4){0.f, 0.f, 0.f, 0.f};
        cur = nxt; cA = nA; cB = nB; ++ui;
        if constexpr (ALIGN_EPI) { if (wr == 1) PG8_BAR; }
    }
    PG8_WAIT_V(0);
    if constexpr (!ALIGN_EPI) { if (wr == 0) PG8_BAR; }
    PG8_BAR;
#undef PG8_SA
#undef PG8_SB
#undef PG8_STAGE
#undef PG8_LDA
#undef PG8_LDB
#undef PG8_MMA
#undef PG8_WAIT_V
#undef PG8_WAIT_L
#undef PG8_BAR
#undef PG8_SCHED
}
}

#define XB_TMO      128
#define XB_XCNT(j)  (256  + 64 * (j))
#define XB_XSUB(j)  (1280 + 64 * (j))
#define XB_XGEN(j)  (2304 + 64 * (j))
#define XB_TOP      3328
#define XB_TOPGEN   3392
#define XCD_BAR_WORDS 3456
#define XB_SPIN_CAP (1u << 18)
__device__ __forceinline__ unsigned xb_ld(unsigned* p)              { return __hip_atomic_load(p, __ATOMIC_RELAXED, __HIP_MEMORY_SCOPE_AGENT); }
__device__ __forceinline__ unsigned xb_add(unsigned* p, unsigned v) { return __hip_atomic_fetch_add(p, v, __ATOMIC_RELAXED, __HIP_MEMORY_SCOPE_AGENT); }
__device__ __forceinline__ unsigned xb_xcc_id() { return (unsigned)__builtin_amdgcn_s_getreg((3 << 11) | 20) & 0xFu; }
#define XB_SPIN(cond, bar) do { unsigned _sp = 0; while (cond) { __builtin_amdgcn_s_sleep(1); \
    if ((++_sp & 255u) == 0u) { if (xb_ld(&(bar)[XB_TMO])) break; if (_sp > XB_SPIN_CAP) { atomicAdd(&(bar)[XB_TMO], 1u); break; } } } } while (0)
struct XcdBarrier { unsigned* bar; unsigned x; volatile LAS unsigned* st; int wave; };
__device__ __forceinline__ XcdBarrier xcd_barrier_post(unsigned* bar, volatile LAS unsigned* st, int wave) {
    XcdBarrier b; b.bar = bar; b.x = xb_xcc_id(); b.st = st; b.wave = wave;
    if (wave == 0 && lane_id() == 0) (void)xb_add(&bar[XB_XCNT(b.x)], 1u);
    return b;
}
__device__ __forceinline__ void xcd_barrier_complete(unsigned* bar, unsigned x, unsigned& nloc, unsigned& nx) {
    const unsigned G = gridDim.x * gridDim.y * gridDim.z;
    unsigned sum, cnt, mine, sp = 0u;
    for (;;) {
        sum = 0u; cnt = 0u; mine = 0u;
#pragma unroll
        for (unsigned j = 0; j < 16; ++j) { const unsigned c = xb_ld(&bar[XB_XCNT(j)]); sum += c; cnt += (c > 0u) ? 1u : 0u; mine = (j == x) ? c : mine; }
        if (sum == G) break;
        __builtin_amdgcn_s_sleep(1);
        if ((++sp & 255u) == 0u) { if (xb_ld(&bar[XB_TMO])) break; if (sp > XB_SPIN_CAP) { atomicAdd(&bar[XB_TMO], 1u); break; } }
    }
    nloc = mine > 0u ? mine : 1u; nx = cnt > 0u ? cnt : 1u;
}
__device__ __forceinline__ void xcd_barrier(const XcdBarrier& b) {
    asm volatile("s_waitcnt vmcnt(0)" ::: "memory");
    __syncthreads();
    if (b.wave == 0 && lane_id() == 0) {
        unsigned* bar = b.bar;
        __builtin_amdgcn_s_waitcnt(0);
        unsigned nloc = b.st[0], nx = b.st[1];
        if (nloc == 0u) { xcd_barrier_complete(bar, b.x, nloc, nx); b.st[0] = nloc; b.st[1] = nx; }
        const unsigned old = xb_add(&bar[XB_XSUB(b.x)], 1u);
        const unsigned gen = old / nloc;
        if (old + 1u == (gen + 1u) * nloc) {
            __builtin_amdgcn_fence(__ATOMIC_RELEASE, "agent");
            asm volatile("s_waitcnt vmcnt(0)" ::: "memory");
            const unsigned og = xb_add(&bar[XB_TOP], 1u);
            const unsigned tg = og / nx;
            if (og + 1u == (tg + 1u) * nx) xb_add(&bar[XB_TOPGEN], 1u);
            else XB_SPIN(xb_ld(&bar[XB_TOPGEN]) == tg, bar);
            __builtin_amdgcn_fence(__ATOMIC_ACQUIRE, "agent");
            xb_add(&bar[XB_XGEN(b.x)], 1u);
            asm volatile("s_waitcnt vmcnt(0)" ::: "memory");
        } else {
            XB_SPIN(xb_ld(&bar[XB_XGEN(b.x)]) == gen, bar);
            __builtin_amdgcn_fence(__ATOMIC_ACQUIRE, "agent");
            asm volatile("s_waitcnt vmcnt(0)" ::: "memory");
        }
    }
    __syncthreads();
}

struct Args {
    const float* x; const float* c; const int* positions; const float* norm_mix_gain; const float* w_ada; const float* b_ada; const float* w_in;
    const float* pool_w; const float* pool_scale; const float* ret_norm_gain; const float* w_branch_pool; const float* w_branch_ret; const float* w_out;
    const float* norm_ffn_gain; const float* peer_w_query; const float* peer_sub_keys; const float* peer_u; const float* peer_v; const float* final_norm_gain;
    float* out; unsigned char* ws; int ph_lo, ph_hi;
};

__device__ __forceinline__ float sigmoidf_(float x) { return __builtin_amdgcn_rcpf(1.0f + __expf(-x)); }

template <int PART  >
struct EpiG1 {
    static constexpr bool PERM = true;
    bf16_t *upool, *q, *k, *v; unsigned char *gret, *sap, *sar; const float *rcos, *rsin; int pn_off;
    __device__ __forceinline__ void operator()(const f32x4 (&acc)[2][2][4][2], const pg8::Unit& u, int wr, int wc, int fr, int fq) const {
        const int pn = u.pn + pn_off, row0 = u.pm * 256 + wr * 64 + fr, cw = wc * 32 + 8 * fq;
        if (pn >= 8 && pn < 24) {
            bf16_t* base = (pn < 16) ? q : k; const int head = (pn - 8) & 7; const float sc = (pn < 16) ? 1.0f : 0.0625f;
#pragma unroll
            for (int ai = 0; ai < 2; ++ai) {
                f32x4 cs[4][4];
#pragma unroll
                for (int m = 0; m < 4; ++m) {
                    const size_t ro = (size_t)(row0 + ai * 128 + m * 16) * 128 + cw;
                    cs[m][0] = *(const f32x4*)(rcos + ro); cs[m][1] = *(const f32x4*)(rcos + ro + 4); cs[m][2] = *(const f32x4*)(rsin + ro); cs[m][3] = *(const f32x4*)(rsin + ro + 4);
                }
                __builtin_amdgcn_sched_barrier(0);
#pragma unroll
                for (int m = 0; m < 4; ++m) {
                    const int row = row0 + ai * 128 + m * 16;
                    const f32x4 c0 = cs[m][0], c1 = cs[m][1], s0 = cs[m][2], s1 = cs[m][3];
                    const f32x4 a0 = acc[ai][0][m][0], a1 = acc[ai][0][m][1], b0 = acc[ai][1][m][0], b1 = acc[ai][1][m][1];
                    const f32x4 p0 = (a0 * c0 - b0 * s0) * sc, p1 = (a1 * c1 - b1 * s1) * sc, r0 = (b0 * c0 + a0 * s0) * sc, r1 = (b1 * c1 + a1 * s1) * sc;
                    bf16_t* rowp = base + (size_t)row * 2048 + head * 256 + cw;
                    u32x4 w; w.x = pk2(p0[0], p0[1]); w.y = pk2(p0[2], p0[3]); w.z = pk2(p1[0], p1[1]); w.w = pk2(p1[2], p1[3]);
                    *(u32x4*)rowp = w;
                    w.x = pk2(r0[0], r0[1]); w.y = pk2(r0[2], r0[3]); w.z = pk2(r1[0], r1[1]); w.w = pk2(r1[2], r1[3]);
                    *(u32x4*)(rowp + 128) = w;
                }
            }
        } else {
            if (PART == 1 && pn >= 56) {
                unsigned char* gb = ((pn < 64) ? sap : sar) + ((pn - 56) & 7) * 256 + cw;
#pragma unroll
                for (int ai = 0; ai < 2; ++ai)
#pragma unroll
                    for (int m = 0; m < 4; ++m) {
                        unsigned char* rowp = gb + (size_t)(row0 + ai * 128 + m * 16) * 2048;
#pragma unroll
                        for (int bj = 0; bj < 2; ++bj) {
                            const f32x4 v0 = acc[ai][bj][m][0], v1 = acc[ai][bj][m][1];
                            unsigned w0 = 0u, w1 = 0u;
                            w0 = __builtin_amdgcn_cvt_pk_u8_f32(sigmoidf_(v0[0]) * 255.0f, 0, w0); w0 = __builtin_amdgcn_cvt_pk_u8_f32(sigmoidf_(v0[1]) * 255.0f, 1, w0);
                            w0 = __builtin_amdgcn_cvt_pk_u8_f32(sigmoidf_(v0[2]) * 255.0f, 2, w0); w0 = __builtin_amdgcn_cvt_pk_u8_f32(sigmoidf_(v0[3]) * 255.0f, 3, w0);
                            w1 = __builtin_amdgcn_cvt_pk_u8_f32(sigmoidf_(v1[0]) * 255.0f, 0, w1); w1 = __builtin_amdgcn_cvt_pk_u8_f32(sigmoidf_(v1[1]) * 255.0f, 1, w1);
                            w1 = __builtin_amdgcn_cvt_pk_u8_f32(sigmoidf_(v1[2]) * 255.0f, 2, w1); w1 = __builtin_amdgcn_cvt_pk_u8_f32(sigmoidf_(v1[3]) * 255.0f, 3, w1);
                            u32x2 w; w.x = w0; w.y = w1; *(u32x2*)(rowp + bj * 128) = w;
                            __builtin_amdgcn_sched_barrier(0);
                        }
                    }
                return;
            }
            if (PART == 1 && pn >= 40) {
                unsigned char* gb = gret + (pn - 40) * 256 + cw;
#pragma unroll
                for (int ai = 0; ai < 2; ++ai)
#pragma unroll
                    for (int m = 0; m < 4; ++m) {
                        unsigned char* rowp = gb + (size_t)(row0 + ai * 128 + m * 16) * 4096;
#pragma unroll
                        for (int bj = 0; bj < 2; ++bj) {
                            f32x4 v0 = acc[ai][bj][m][0], v1 = acc[ai][bj][m][1];
#pragma unroll
                            for (int j = 0; j < 4; ++j) { v0[j] *= sigmoidf_(v0[j]); v1[j] *= sigmoidf_(v1[j]); }
                            int w0 = __builtin_amdgcn_cvt_pk_fp8_f32(v0[0], v0[1], 0, false); w0 = __builtin_amdgcn_cvt_pk_fp8_f32(v0[2], v0[3], w0, true);
                            int w1 = __builtin_amdgcn_cvt_pk_fp8_f32(v1[0], v1[1], 0, false); w1 = __builtin_amdgcn_cvt_pk_fp8_f32(v1[2], v1[3], w1, true);
                            u32x2 w; w.x = (unsigned)w0; w.y = (unsigned)w1; *(u32x2*)(rowp + bj * 128) = w;
                            __builtin_amdgcn_sched_barrier(0);
                        }
                    }
                return;
            }
            bf16_t* base; int ldc, col; constexpr int kind = 0;
            if (pn < 8) { base = upool; ldc = 2048; col = pn * 256; }
            else { base = v; ldc = 4096; col = (pn - 24) * 256; }
#pragma unroll
            for (int ai = 0; ai < 2; ++ai)
#pragma unroll
                for (int m = 0; m < 4; ++m) {
                    bf16_t* rowp = base + (size_t)(row0 + ai * 128 + m * 16) * ldc + col + cw;
#pragma unroll
                    for (int bj = 0; bj < 2; ++bj) {
                        f32x4 v0 = acc[ai][bj][m][0], v1 = acc[ai][bj][m][1];
                        if (kind != 0) {
#pragma unroll
                            for (int j = 0; j < 4; ++j) { const float g0 = sigmoidf_(v0[j]), g1 = sigmoidf_(v1[j]); v0[j] = (kind == 1) ? v0[j] * g0 : g0; v1[j] = (kind == 1) ? v1[j] * g1 : g1; }
                        }
                        u32x4 w; w.x = pk2(v0[0], v0[1]); w.y = pk2(v0[2], v0[3]); w.z = pk2(v1[0], v1[1]); w.w = pk2(v1[2], v1[3]);
                        *(u32x4*)(rowp + bj * 128) = w;
                    }
                }
        }
    }
};

template <int ADD> struct EpiGate {
    static constexpr bool PERM = true;
    const unsigned char* gate; bf16_t* out;
    __device__ __forceinline__ void operator()(const f32x4 (&acc)[2][2][4][2], const pg8::Unit& u, int wr, int wc, int fr, int fq) const {
        const int row0 = u.pm * 256 + wr * 64 + fr, col0 = u.pn * 256 + wc * 32 + 8 * fq;
#pragma unroll
        for (int ai = 0; ai < 2; ++ai) {
            u32x2 gv[4][2]; u32x4 pv[4][2];
#pragma unroll
            for (int m = 0; m < 4; ++m)
#pragma unroll
                for (int bj = 0; bj < 2; ++bj) { const size_t off = (size_t)(row0 + ai * 128 + m * 16) * 2048 + col0 + bj * 128; gv[m][bj] = *(const u32x2*)(gate + off); if (ADD) pv[m][bj] = *(const u32x4*)(out + off); }
            __builtin_amdgcn_sched_barrier(0);
#pragma unroll
            for (int m = 0; m < 4; ++m)
#pragma unroll
                for (int bj = 0; bj < 2; ++bj) {
                    const size_t off = (size_t)(row0 + ai * 128 + m * 16) * 2048 + col0 + bj * 128;
                    const u32x2 g = gv[m][bj]; constexpr float U8 = 1.0f / 255.0f;
                    f32x4 v0 = acc[ai][bj][m][0], v1 = acc[ai][bj][m][1];
                    v0[0] *= (float)(g.x & 0xffu) * U8; v0[1] *= (float)((g.x >> 8) & 0xffu) * U8; v0[2] *= (float)((g.x >> 16) & 0xffu) * U8; v0[3] *= (float)(g.x >> 24) * U8;
                    v1[0] *= (float)(g.y & 0xffu) * U8; v1[1] *= (float)((g.y >> 8) & 0xffu) * U8; v1[2] *= (float)((g.y >> 16) & 0xffu) * U8; v1[3] *= (float)(g.y >> 24) * U8;
                    if (ADD) { const u32x4 pq = pv[m][bj];
                        v0[0] += bf_lo(pq.x); v0[1] += bf_hi(pq.x); v0[2] += bf_lo(pq.y); v0[3] += bf_hi(pq.y);
                        v1[0] += bf_lo(pq.z); v1[1] += bf_hi(pq.z); v1[2] += bf_lo(pq.w); v1[3] += bf_hi(pq.w); }
                    u32x4 w; w.x = pk2(v0[0], v0[1]); w.y = pk2(v0[2], v0[3]); w.z = pk2(v1[0], v1[1]); w.w = pk2(v1[2], v1[3]);
                    *(u32x4*)(out + off) = w;
                }
        }
    }
};

struct EpiRes {
    static constexpr bool PERM = false;
    const float* x; float* out; const long long* modacc; const float* b_ada;
    __device__ __forceinline__ void operator()(const f32x4 (&acc)[2][2][4][2], const pg8::Unit& u, int wr, int wc, int fr, int fq) const {
        const int row0 = u.pm * 256 + wr * 64 + fr, col0 = u.pn * 256 + wc * 32 + 4 * fq;
        f32x4 gv[2][2];
#pragma unroll
        for (int bj = 0; bj < 2; ++bj)
#pragma unroll
            for (int n = 0; n < 2; ++n) { const int c = 2 * D + col0 + bj * 128 + n * 16; gv[bj][n] = (f32x4){modval(modacc, b_ada, c), modval(modacc, b_ada, c + 1), modval(modacc, b_ada, c + 2), modval(modacc, b_ada, c + 3)}; }
#pragma unroll
        for (int ai = 0; ai < 2; ++ai) {
            f32x4 xv[4][2][2];
#pragma unroll
            for (int m = 0; m < 4; ++m)
#pragma unroll
                for (int bj = 0; bj < 2; ++bj)
#pragma unroll
                    for (int n = 0; n < 2; ++n) xv[m][bj][n] = *(const f32x4*)(x + (size_t)(row0 + ai * 128 + m * 16) * 2048 + col0 + bj * 128 + n * 16);
            __builtin_amdgcn_sched_barrier(0);
#pragma unroll
            for (int m = 0; m < 4; ++m)
#pragma unroll
                for (int bj = 0; bj < 2; ++bj)
#pragma unroll
                    for (int n = 0; n < 2; ++n) *(f32x4*)(out + (size_t)(row0 + ai * 128 + m * 16) * 2048 + col0 + bj * 128 + n * 16) = xv[m][bj][n] + gv[bj][n] * acc[ai][bj][m][n];
        }
    }
};

struct EpiBf16Plain {
    static constexpr bool PERM = true;
    bf16_t* out;
    __device__ __forceinline__ void operator()(const f32x4 (&acc)[2][2][4][2], const pg8::Unit& u, int wr, int wc, int fr, int fq) const {
        const int row0 = u.pm * 256 + wr * 64 + fr, col0 = u.pn * 256 + wc * 32 + 8 * fq;
#pragma unroll
        for (int ai = 0; ai < 2; ++ai)
#pragma unroll
            for (int m = 0; m < 4; ++m) {
                bf16_t* rowp = out + (size_t)(row0 + ai * 128 + m * 16) * 2048 + col0;
#pragma unroll
                for (int bj = 0; bj < 2; ++bj) { const f32x4 v0 = acc[ai][bj][m][0], v1 = acc[ai][bj][m][1];
                    u32x4 w; w.x = pk2(v0[0], v0[1]); w.y = pk2(v0[2], v0[3]); w.z = pk2(v1[0], v1[1]); w.w = pk2(v1[2], v1[3]);
                    *(u32x4*)(rowp + bj * 128) = w; }
            }
    }
};

struct EpiF32 {
    static constexpr bool PERM = false;
    float* out;
    __device__ __forceinline__ void operator()(const f32x4 (&acc)[2][2][4][2], const pg8::Unit& u, int wr, int wc, int fr, int fq) const {
        const int row0 = u.pm * 256 + wr * 64 + fr, col0 = u.pn * 256 + wc * 32 + 4 * fq;
#pragma unroll
        for (int ai = 0; ai < 2; ++ai)
#pragma unroll
            for (int m = 0; m < 4; ++m) {
                float* rowp = out + (size_t)(row0 + ai * 128 + m * 16) * 2048 + col0;
#pragma unroll
                for (int bj = 0; bj < 2; ++bj)
#pragma unroll
                    for (int n = 0; n < 2; ++n) *(f32x4*)(rowp + bj * 128 + n * 16) = acc[ai][bj][m][n];
            }
    }
};

__device__ __forceinline__ void transpose_item(const float* W, int K, int N, bf16_t* WT, LAS float* scr, int item, int lane, int n8 = 1 << 30, unsigned char* WT8 = nullptr) {
    const int nblk = N / 32, kb = item / nblk, nb = item % nblk, k0 = 64 * kb, n0 = 32 * nb;
    float tv[32];
#pragma unroll
    for (int i = 0; i < 32; ++i) tv[i] = __builtin_nontemporal_load(&W[(size_t)(k0 + 2 * i + (lane >> 5)) * N + n0 + (lane & 31)]);
#pragma unroll
    for (int i = 0; i < 32; ++i) scr[(2 * i + (lane >> 5)) * 33 + (lane & 31)] = tv[i];
    LDS_WAIT();
    const int c = lane & 7;
    if (n0 >= n8) {
#pragma unroll
        for (int j = 0; j < 4; ++j) { const int n = (lane >> 3) + 8 * j; const LAS float* s = scr + (8 * c) * 33 + n;
            int w0 = __builtin_amdgcn_cvt_pk_fp8_f32(s[0 * 33] * 512.0f, s[1 * 33] * 512.0f, 0, false); w0 = __builtin_amdgcn_cvt_pk_fp8_f32(s[2 * 33] * 512.0f, s[3 * 33] * 512.0f, w0, true);
            int w1 = __builtin_amdgcn_cvt_pk_fp8_f32(s[4 * 33] * 512.0f, s[5 * 33] * 512.0f, 0, false); w1 = __builtin_amdgcn_cvt_pk_fp8_f32(s[6 * 33] * 512.0f, s[7 * 33] * 512.0f, w1, true);
            u32x2 o; o.x = (unsigned)w0; o.y = (unsigned)w1; *(u32x2*)(WT8 + (size_t)(n0 + n - n8) * K + k0 + 8 * c) = o; }
        LDS_WAIT();
        return;
    }
#pragma unroll
    for (int j = 0; j < 4; ++j) { const int n = (lane >> 3) + 8 * j; const LAS float* s = scr + (8 * c) * 33 + n;
        u32x4 o; o.x = pk2(s[0 * 33], s[1 * 33]); o.y = pk2(s[2 * 33], s[3 * 33]); o.z = pk2(s[4 * 33], s[5 * 33]); o.w = pk2(s[6 * 33], s[7 * 33]);
        *(u32x4*)(WT + (size_t)(n0 + n) * K + k0 + 8 * c) = o; }
    LDS_WAIT();
}

template <bool W8 = false>
__device__ __forceinline__ void norm_mod_row2(const float* xrow0, const float* xrow1, const float* gain, const LAS float* shl, const LAS float* scl, bf16_t* orow0, bf16_t* orow1, int lane, unsigned char* o8row0 = nullptr, unsigned char* o8row1 = nullptr) {
    const f32x4* xr0 = (const f32x4*)xrow0 + lane; const f32x4* xr1 = (const f32x4*)xrow1 + lane;
    f32x4 v0[8], v1[8]; float s0 = 0.f, s1 = 0.f;
#pragma unroll
    for (int j = 0; j < 8; ++j) { v0[j] = W8 ? __builtin_nontemporal_load(&xr0[64 * j]) : xr0[64 * j]; v1[j] = W8 ? __builtin_nontemporal_load(&xr1[64 * j]) : xr1[64 * j]; }
#pragma unroll
    for (int j = 0; j < 8; ++j) { s0 += (v0[j].x * v0[j].x + v0[j].y * v0[j].y) + (v0[j].z * v0[j].z + v0[j].w * v0[j].w); s1 += (v1[j].x * v1[j].x + v1[j].y * v1[j].y) + (v1[j].z * v1[j].z + v1[j].w * v1[j].w); }
    const float rstd0 = 1.0f / sqrtf(wave_sum(s0) * (1.0f / D) + EPS), rstd1 = 1.0f / sqrtf(wave_sum(s1) * (1.0f / D) + EPS);
    u32x2* o80 = (u32x2*)orow0 + lane; u32x2* o81 = (u32x2*)orow1 + lane;
#pragma unroll
    for (int j = 0; j < 8; ++j) {
        const int c = 256 * j + 4 * lane;
        const f32x4 g = *(const f32x4*)(gain + c);
        const f32x4 sc = *(const LAS f32x4*)(scl + c) + 1.0f;
        const f32x4 sh = *(const LAS f32x4*)(shl + c);
        const f32x4 y0 = (v0[j] * rstd0 * g) * sc + sh, y1 = (v1[j] * rstd1 * g) * sc + sh;
        u32x2 w; w.x = pk2(y0.x, y0.y); w.y = pk2(y0.z, y0.w); o80[64 * j] = w;
        w.x = pk2(y1.x, y1.y); w.y = pk2(y1.z, y1.w); o81[64 * j] = w;
        if (W8) {
            int q0 = __builtin_amdgcn_cvt_pk_fp8_f32(y0.x * 8.0f, y0.y * 8.0f, 0, false); q0 = __builtin_amdgcn_cvt_pk_fp8_f32(y0.z * 8.0f, y0.w * 8.0f, q0, true);
            int q1 = __builtin_amdgcn_cvt_pk_fp8_f32(y1.x * 8.0f, y1.y * 8.0f, 0, false); q1 = __builtin_amdgcn_cvt_pk_fp8_f32(y1.z * 8.0f, y1.w * 8.0f, q1, true);
            ((unsigned*)o8row0)[64 * j + lane] = (unsigned)q0; ((unsigned*)o8row1)[64 * j + lane] = (unsigned)q1;
        }
    }
}

__device__ __forceinline__ unsigned fkey(float f) { const unsigned u = __builtin_bit_cast(unsigned, f); return (u & 0x80000000u) ? ~u : (u | 0x80000000u); }
__device__ __forceinline__ float fkey_inv(unsigned k) { const unsigned u = (k & 0x80000000u) ? (k & 0x7fffffffu) : ~k; return __builtin_bit_cast(float, u); }
__device__ __forceinline__ unsigned long long wave_max_u64(unsigned long long v) {
#pragma unroll
    for (int o = 1; o < 64; o <<= 1) { const unsigned long long t = __shfl_xor(v, o); v = t > v ? t : v; }
    return v;
}
__device__ __forceinline__ int okey(float f) { const int b = __builtin_bit_cast(int, f); return b ^ ((b >> 31) & 0x7fffffff); }
__device__ __forceinline__ float okey_inv(int k) { const int b = k ^ ((k >> 31) & 0x7fffffff); return __builtin_bit_cast(float, b); }
__device__ __forceinline__ float gelu_tanh(float x) { const float t = 0.7978845608028654f * (x + 0.044715f * x * x * x); return 0.5f * x * (1.0f + tanhf(t)); }


constexpr int RC = 64, RSEG = 8, RSEGLEN = S / RSEG, RNCH = RSEGLEN / RC;
constexpr int QS_OFF = 0, QS_STRIDE = 528, KS_OFF = 33792, VS_OFF = 67584, VS_STRIDE = 272, PS_OFF = 84992, PS_STRIDE = 144;
typedef short s16x4 __attribute__((ext_vector_type(4)));
__device__ __forceinline__ bf16x8 tr_frag(LAS unsigned char* base, int stride, int lane) {
    const int g4 = lane >> 4, q = (lane & 15) >> 2, p = lane & 3;
    LAS unsigned char* a0 = base + (8 * g4 + q) * stride + 8 * p;
    const s16x4 lo = __builtin_amdgcn_ds_read_tr16_b64_v4i16((LAS s16x4*)a0);
    const s16x4 hi = __builtin_amdgcn_ds_read_tr16_b64_v4i16((LAS s16x4*)(a0 + 4 * stride));
    return __builtin_shufflevector(lo, hi, 0, 1, 2, 3, 4, 5, 6, 7);
}
constexpr int TS_OFF = 98304;
constexpr int NHP = 4 * NE;
__device__ __forceinline__ const float* tab_src(const float* pu, const float* pv, int p) { return ((p >= 2 * NE) ? pv : pu) + (size_t)(p & (2 * NE - 1)) * 1024; }
__device__ __forceinline__ unsigned char* tab_dst(unsigned char* ut, unsigned char* vt, int p) { return ((p >= 2 * NE) ? vt : ut) + (size_t)(p & (2 * NE - 1)) * 512; }
__device__ __forceinline__ void tab4_half_store(const f32x4 (&xv)[4], float scl, unsigned char* dst) {
    unsigned w0 = 0u, w1 = 0u;
#define TAB4_Q(w_, q_, s0_, s1_) do { \
        const float e0_ = __builtin_amdgcn_fmed3f(xv[q_][0] * scl, -6.0f, 6.0f), e1_ = __builtin_amdgcn_fmed3f(xv[q_][1] * scl, -6.0f, 6.0f); \
        const float e2_ = __builtin_amdgcn_fmed3f(xv[q_][2] * scl, -6.0f, 6.0f), e3_ = __builtin_amdgcn_fmed3f(xv[q_][3] * scl, -6.0f, 6.0f); \
        w_ = __builtin_amdgcn_cvt_scalef32_pk_fp4_f32(w_, e0_, e1_, 1.0f, s0_); w_ = __builtin_amdgcn_cvt_scalef32_pk_fp4_f32(w_, e2_, e3_, 1.0f, s1_); } while (0)
    TAB4_Q(w0, 0, 0, 1); TAB4_Q(w0, 1, 2, 3); TAB4_Q(w1, 2, 0, 1); TAB4_Q(w1, 3, 2, 3);
#undef TAB4_Q
    u32x2 o; o.x = w0; o.y = w1; *(u32x2*)dst = o;
}
__device__ __forceinline__ void tab_dma(const float* gsrc, unsigned lds_dst) {
    unsigned keep;
    asm volatile("s_mov_b32 %0, m0\n\ts_mov_b32 m0, %2\n\ts_nop 0\n\t"
                 "global_load_lds_dwordx4 %1, off nt\n\tglobal_load_lds_dwordx4 %1, off offset:1024 nt\n\t"
                 "global_load_lds_dwordx4 %1, off offset:2048 nt\n\tglobal_load_lds_dwordx4 %1, off offset:3072 nt\n\t"
                 "s_mov_b32 m0, %0" : "=&s"(keep) : "v"(gsrc), "s"(lds_dst) : "memory");
}
template <bool FULL>
__device__ __forceinline__ int ret_pass(LAS unsigned char* lds, const bf16_t* qb, const bf16_t* kb, bf16_t* vb, float* Lbuf, int unit, int tid, int lane, int wave,
                                        const float* tj_pu, const float* tj_pv, unsigned char* tj_ut, unsigned char* tj_vt, float tj_su, float tj_sv, int tj_p, int tj_step) {
    const int h = unit >> 5, vq = (unit >> 3) & 3, g = unit & 7;
    if (!FULL && g == RSEG - 1) return tj_p;
    const int fr = lane & 15, g4 = lane >> 4;
    constexpr bool TJ = FULL && (TAB_IN_RET != 0);
    const unsigned ts_lds = (unsigned)__builtin_amdgcn_readfirstlane((int)(unsigned)(size_t)(lds + TS_OFF + wave * 4096));
    if (TJ && tj_p < NHP) tab_dma(tab_src(tj_pu, tj_pv, tj_p) + 4 * lane, ts_lds);
    const float lg = log2f(1.0f - exp2f(-5.0f - (float)h));
    const float gC = exp2f(64.0f * lg), gsc = exp2f(-64.0f * lg);
    float kd[4];
#pragma unroll
    for (int i = 0; i < 4; ++i) kd[i] = exp2f((float)(63 - ((tid >> 5) + 16 * i)) * lg);
    f32x4 st[16];
#pragma unroll
    for (int dt = 0; dt < 16; ++dt) st[dt] = (f32x4){0.f, 0.f, 0.f, 0.f};
    if (FULL) {
        const float gS = exp2f((float)RSEGLEN * lg);
        for (int gp = 0; gp < g; ++gp) {
            const f32x4* Lp = (const f32x4*)Lbuf + ((size_t)(((gp * 8 + h) * 4 + vq) * 8 + wave) * 16) * 64 + lane;
            f32x4 tmp[16];
#pragma unroll
            for (int dt = 0; dt < 16; ++dt) tmp[dt] = Lp[dt * 64];
            __builtin_amdgcn_sched_barrier(0);
#pragma unroll
            for (int dt = 0; dt < 16; ++dt) st[dt] = st[dt] * gS + tmp[dt];
        }
    }
    const int tbase = g * RSEGLEN;
    const bf16_t* qg = qb + (size_t)(tbase + (tid >> 5)) * 2048 + h * 256 + (tid & 31) * 8;
    const bf16_t* kg = kb + (size_t)(tbase + (tid >> 5)) * 2048 + h * 256 + (tid & 31) * 8;
    const bf16_t* vg = vb + (size_t)(tbase + (tid >> 4)) * 4096 + h * 512 + vq * 128 + (tid & 15) * 8;
    u32x4 pq[4], pk[4], pv[2];
    if (FULL) {
#pragma unroll
        for (int i = 0; i < 4; ++i) pq[i] = *(const u32x4*)(qg + (size_t)(16 * i) * 2048);
    }
#pragma unroll
    for (int i = 0; i < 4; ++i) pk[i] = *(const u32x4*)(kg + (size_t)(16 * i) * 2048);
#pragma unroll
    for (int i = 0; i < 2; ++i) pv[i] = *(const u32x4*)(vg + (size_t)(32 * i) * 4096);
    for (int c = 0; c < RNCH; ++c) {
        if (FULL) {
#pragma unroll
            for (int i = 0; i < 4; ++i) *(LAS u32x4*)(lds + QS_OFF + ((tid >> 5) + 16 * i) * QS_STRIDE + (tid & 31) * 16) = pq[i];
        }
#pragma unroll
        for (int i = 0; i < 4; ++i) {
            const float kc = kd[i];
            u32x4 w; w.x = pk2(bf_lo(pk[i].x) * kc, bf_hi(pk[i].x) * kc); w.y = pk2(bf_lo(pk[i].y) * kc, bf_hi(pk[i].y) * kc); w.z = pk2(bf_lo(pk[i].z) * kc, bf_hi(pk[i].z) * kc); w.w = pk2(bf_lo(pk[i].w) * kc, bf_hi(pk[i].w) * kc);
            *(LAS u32x4*)(lds + KS_OFF + ((tid >> 5) + 16 * i) * QS_STRIDE + (tid & 31) * 16) = w;
        }
#pragma unroll
        for (int i = 0; i < 2; ++i) *(LAS u32x4*)(lds + VS_OFF + ((tid >> 4) + 32 * i) * VS_STRIDE + (tid & 15) * 16) = pv[i];
        if (TJ) {
            __builtin_amdgcn_sched_barrier(0);
            asm volatile("s_waitcnt vmcnt(0)" ::: "memory");
            if (tj_p < NHP) {
                f32x4 xv[4];
#pragma unroll
                for (int q = 0; q < 4; ++q) xv[q] = *(const LAS f32x4*)(lds + TS_OFF + wave * 4096 + 64 * lane + 16 * q);
                tab4_half_store(xv, (tj_p >= 2 * NE) ? tj_sv : tj_su, tab_dst(tj_ut, tj_vt, tj_p) + 8 * lane);
            }
            tj_p += tj_step;
            if (c + 1 < RNCH && tj_p < NHP) tab_dma(tab_src(tj_pu, tj_pv, tj_p) + 4 * lane, ts_lds);
            __builtin_amdgcn_sched_barrier(0);
        }
        if (c + 1 < RNCH) {
            const size_t adv = (size_t)(c + 1) * RC;
            if (FULL) {
#pragma unroll
                for (int i = 0; i < 4; ++i) pq[i] = *(const u32x4*)(qg + (adv + 16 * i) * 2048);
            }
#pragma unroll
            for (int i = 0; i < 4; ++i) pk[i] = *(const u32x4*)(kg + (adv + 16 * i) * 2048);
#pragma unroll
            for (int i = 0; i < 2; ++i) pv[i] = *(const u32x4*)(vg + (adv + 32 * i) * 4096);
        }
        __syncthreads();
        if (FULL) {
            const int rt = wave >> 1, ctb = (wave & 1) * 2;
            f32x4 pacc0 = (f32x4){0.f, 0.f, 0.f, 0.f}, pacc1 = (f32x4){0.f, 0.f, 0.f, 0.f};
#pragma unroll
            for (int kh = 0; kh < 2; ++kh) {
                bf16x8 qa[4], kb0[4], kb1[4];
#pragma unroll
                for (int k2 = 0; k2 < 4; ++k2) { const int ks = 4 * kh + k2;
                    qa[k2] = *(const LAS bf16x8*)(lds + QS_OFF + (16 * rt + fr) * QS_STRIDE + 64 * ks + 16 * g4);
                    kb0[k2] = *(const LAS bf16x8*)(lds + KS_OFF + (16 * ctb + fr) * QS_STRIDE + 64 * ks + 16 * g4);
                    kb1[k2] = *(const LAS bf16x8*)(lds + KS_OFF + (16 * ctb + 16 + fr) * QS_STRIDE + 64 * ks + 16 * g4); }
                __builtin_amdgcn_sched_barrier(0);
#pragma unroll
                for (int k2 = 0; k2 < 4; ++k2) {
                    pacc0 = __builtin_amdgcn_mfma_f32_16x16x32_bf16(qa[k2], kb0[k2], pacc0, 0, 0, 0);
                    pacc1 = __builtin_amdgcn_mfma_f32_16x16x32_bf16(qa[k2], kb1[k2], pacc1, 0, 0, 0);
                }
                __builtin_amdgcn_sched_barrier(0);
            }
#pragma unroll
            for (int cc = 0; cc < 2; ++cc) {
                const int j = 16 * (ctb + cc) + fr;
#pragma unroll
                for (int r = 0; r < 4; ++r) {
                    const int i = 16 * rt + 4 * g4 + r;
                    const float pa = cc ? pacc1[r] : pacc0[r];
                    const float pvv = (j <= i) ? pa * gsc : 0.f;
                    *(LAS unsigned short*)(lds + PS_OFF + i * PS_STRIDE + 2 * j) = (unsigned short)(pk2(pvv, 0.f) & 0xffffu);
                }
            }
            __syncthreads();
        }
        bf16x8 vf[2];
        vf[0] = tr_frag(lds + VS_OFF + 32 * wave, VS_STRIDE, lane);
        vf[1] = tr_frag(lds + VS_OFF + 32 * VS_STRIDE + 32 * wave, VS_STRIDE, lane);
        bf16x8 kf[3][2][2];
#define RET_LDK(buf, dtb) do { _Pragma("unroll") for (int d2 = 0; d2 < 2; ++d2) _Pragma("unroll") for (int ks = 0; ks < 2; ++ks) \
            kf[buf][d2][ks] = tr_frag(lds + KS_OFF + 32 * ks * QS_STRIDE + 32 * ((dtb) + d2), QS_STRIDE, lane); } while (0)
#define RET_UPD(buf, dtb) do { _Pragma("unroll") for (int d2 = 0; d2 < 2; ++d2) st[(dtb) + d2] = st[(dtb) + d2] * gC; \
            _Pragma("unroll") for (int ks = 0; ks < 2; ++ks) _Pragma("unroll") for (int d2 = 0; d2 < 2; ++d2) \
                st[(dtb) + d2] = __builtin_amdgcn_mfma_f32_16x16x32_bf16(kf[buf][d2][ks], vf[ks], st[(dtb) + d2], 0, 0, 0); } while (0)
        if (FULL) {
            f32x4 o[4];
#pragma unroll
            for (int rt = 0; rt < 4; ++rt) o[rt] = (f32x4){0.f, 0.f, 0.f, 0.f};
            u32x4 qf[3][4];
#define RET_LDQ(buf, ks) do { _Pragma("unroll") for (int rt = 0; rt < 4; ++rt) { \
                const u32x2 a0 = *(const LAS u32x2*)(lds + QS_OFF + (16 * rt + fr) * QS_STRIDE + 64 * (ks) + 8 * g4); \
                const u32x2 a1 = *(const LAS u32x2*)(lds + QS_OFF + (16 * rt + fr) * QS_STRIDE + 64 * (ks) + 32 + 8 * g4); \
                qf[buf][rt].x = a0.x; qf[buf][rt].y = a0.y; qf[buf][rt].z = a1.x; qf[buf][rt].w = a1.y; } } while (0)
#define RET_CROSS(buf, ks) do { \
                u32x4 sb; sb.x = pk2(st[2 * (ks)][0], st[2 * (ks)][1]); sb.y = pk2(st[2 * (ks)][2], st[2 * (ks)][3]); sb.z = pk2(st[2 * (ks) + 1][0], st[2 * (ks) + 1][1]); sb.w = pk2(st[2 * (ks) + 1][2], st[2 * (ks) + 1][3]); \
                const bf16x8 sfrag = __builtin_bit_cast(bf16x8, sb); \
                _Pragma("unroll") for (int rt = 0; rt < 4; ++rt) o[rt] = __builtin_amdgcn_mfma_f32_16x16x32_bf16(__builtin_bit_cast(bf16x8, qf[buf][rt]), sfrag, o[rt], 0, 0, 0); } while (0)
            {
                bf16x8 pf[4][2];
#pragma unroll
                for (int rt = 0; rt < 4; ++rt)
#pragma unroll
                    for (int ks = 0; ks < 2; ++ks) pf[rt][ks] = *(const LAS bf16x8*)(lds + PS_OFF + (16 * rt + fr) * PS_STRIDE + 64 * ks + 16 * g4);
                RET_LDQ(0, 0); RET_LDQ(1, 1);
                __builtin_amdgcn_sched_barrier(0);
#pragma unroll
                for (int ks = 0; ks < 2; ++ks)
#pragma unroll
                    for (int rt = 0; rt < 4; ++rt) o[rt] = __builtin_amdgcn_mfma_f32_16x16x32_bf16(pf[rt][ks], vf[ks], o[rt], 0, 0, 0);
            }
            __builtin_amdgcn_sched_barrier(0);
            RET_LDQ(2, 2); RET_CROSS(0, 0); __builtin_amdgcn_sched_barrier(0);
            RET_LDQ(0, 3); RET_CROSS(1, 1); __builtin_amdgcn_sched_barrier(0);
            RET_LDQ(1, 4); RET_CROSS(2, 2); __builtin_amdgcn_sched_barrier(0);
            RET_LDQ(2, 5); RET_CROSS(0, 3); __builtin_amdgcn_sched_barrier(0);
            RET_LDQ(0, 6); RET_CROSS(1, 4); __builtin_amdgcn_sched_barrier(0);
            RET_LDQ(1, 7); RET_CROSS(2, 5); __builtin_amdgcn_sched_barrier(0);
            RET_LDK(0, 0); RET_CROSS(0, 6); __builtin_amdgcn_sched_barrier(0);
            RET_LDK(1, 2); RET_CROSS(1, 7); __builtin_amdgcn_sched_barrier(0);
#undef RET_LDQ
#undef RET_CROSS
            const float gb = exp2f((float)(4 * g4 + 1) * lg), g1 = exp2f(lg), g16 = exp2f(16.0f * lg);
            bf16_t* yp = vb + (size_t)(tbase + c * RC) * 4096 + h * 512 + vq * 128 + 16 * wave + fr;
            float frt = gb;
#pragma unroll
            for (int rt = 0; rt < 4; ++rt) {
                float f = frt;
#pragma unroll
                for (int r = 0; r < 4; ++r) { yp[(size_t)(16 * rt + 4 * g4 + r) * 4096] = (bf16_t)(pk2(o[rt][r] * f, 0.f) & 0xffffu); f *= g1; }
                frt *= g16;
            }
        } else {
            RET_LDK(0, 0); RET_LDK(1, 2);
        }
        __builtin_amdgcn_sched_barrier(0);
        RET_LDK(2, 4); RET_UPD(0, 0); __builtin_amdgcn_sched_barrier(0);
        RET_LDK(0, 6); RET_UPD(1, 2); __builtin_amdgcn_sched_barrier(0);
        RET_LDK(1, 8); RET_UPD(2, 4); __builtin_amdgcn_sched_barrier(0);
        RET_LDK(2, 10); RET_UPD(0, 6); __builtin_amdgcn_sched_barrier(0);
        RET_LDK(0, 12); RET_UPD(1, 8); __builtin_amdgcn_sched_barrier(0);
        RET_LDK(1, 14); RET_UPD(2, 10); __builtin_amdgcn_sched_barrier(0);
        RET_UPD(0, 12); RET_UPD(1, 14);
#undef RET_LDK
#undef RET_UPD
        __syncthreads();
    }
    if (!FULL) {
        f32x4* Lp = (f32x4*)Lbuf + ((size_t)(((g * 8 + h) * 4 + vq) * 8 + wave) * 16) * 64 + lane;
#pragma unroll
        for (int dt = 0; dt < 16; ++dt) Lp[dt * 64] = st[dt];
    }
    return tj_p;
}

__device__ __forceinline__ void ret_pass1(LAS unsigned char* lds, const bf16_t* kb, const bf16_t* vb, float* Lbuf, int unit, int tid, int lane, int wave) {
    const int h = unit >> 5, vq = (unit >> 3) & 3, g = unit & 7;
    if (g == RSEG - 1) return;
    const float lg = log2f(1.0f - exp2f(-5.0f - (float)h));
    const float gC = exp2f(64.0f * lg);
    float kd[4];
#pragma unroll
    for (int i = 0; i < 4; ++i) kd[i] = exp2f((float)(63 - ((tid >> 5) + 16 * i)) * lg);
    f32x4 st[16];
#pragma unroll
    for (int dt = 0; dt < 16; ++dt) st[dt] = (f32x4){0.f, 0.f, 0.f, 0.f};
    const int tbase = g * RSEGLEN;
    const bf16_t* kg = kb + (size_t)(tbase + (tid >> 5)) * 2048 + h * 256 + (tid & 31) * 8;
    const bf16_t* vg = vb + (size_t)(tbase + (tid >> 4)) * 4096 + h * 512 + vq * 128 + (tid & 15) * 8;
    u32x4 pkA[4], pvA[2], pkB[4], pvB[2];
#define P1_PREFETCH(pk_, pv_, cc_) do { const size_t adv_ = (size_t)(cc_) * RC; \
        _Pragma("unroll") for (int i = 0; i < 4; ++i) pk_[i] = *(const u32x4*)(kg + (adv_ + 16 * i) * 2048); \
        _Pragma("unroll") for (int i = 0; i < 2; ++i) pv_[i] = *(const u32x4*)(vg + (adv_ + 32 * i) * 4096); } while (0)
#define P1_LDK(buf, dtb) do { _Pragma("unroll") for (int d2 = 0; d2 < 2; ++d2) _Pragma("unroll") for (int ks = 0; ks < 2; ++ks) \
        kf[buf][d2][ks] = tr_frag(lds + KS_OFF + 32 * ks * QS_STRIDE + 32 * ((dtb) + d2), QS_STRIDE, lane); } while (0)
#define P1_UPD(buf, dtb) do { _Pragma("unroll") for (int d2 = 0; d2 < 2; ++d2) st[(dtb) + d2] = st[(dtb) + d2] * gC; \
        _Pragma("unroll") for (int ks = 0; ks < 2; ++ks) _Pragma("unroll") for (int d2 = 0; d2 < 2; ++d2) \
            st[(dtb) + d2] = __builtin_amdgcn_mfma_f32_16x16x32_bf16(kf[buf][d2][ks], vf[ks], st[(dtb) + d2], 0, 0, 0); } while (0)
#define P1_CHUNK(pk_, pv_, cpre_) do { \
        _Pragma("unroll") for (int i = 0; i < 4; ++i) { const float kc = kd[i]; \
            u32x4 w; w.x = pk2(bf_lo(pk_[i].x) * kc, bf_hi(pk_[i].x) * kc); w.y = pk2(bf_lo(pk_[i].y) * kc, bf_hi(pk_[i].y) * kc); w.z = pk2(bf_lo(pk_[i].z) * kc, bf_hi(pk_[i].z) * kc); w.w = pk2(bf_lo(pk_[i].w) * kc, bf_hi(pk_[i].w) * kc); \
            *(LAS u32x4*)(lds + KS_OFF + ((tid >> 5) + 16 * i) * QS_STRIDE + (tid & 31) * 16) = w; } \
        _Pragma("unroll") for (int i = 0; i < 2; ++i) *(LAS u32x4*)(lds + VS_OFF + ((tid >> 4) + 32 * i) * VS_STRIDE + (tid & 15) * 16) = pv_[i]; \
        if ((cpre_) < RNCH) P1_PREFETCH(pk_, pv_, cpre_); \
        __syncthreads(); \
        bf16x8 vf[2]; vf[0] = tr_frag(lds + VS_OFF + 32 * wave, VS_STRIDE, lane); vf[1] = tr_frag(lds + VS_OFF + 32 * VS_STRIDE + 32 * wave, VS_STRIDE, lane); \
        bf16x8 kf[3][2][2]; \
        P1_LDK(0, 0); P1_LDK(1, 2); __builtin_amdgcn_sched_barrier(0); \
        P1_LDK(2, 4); P1_UPD(0, 0); __builtin_amdgcn_sched_barrier(0); \
        P1_LDK(0, 6); P1_UPD(1, 2); __builtin_amdgcn_sched_barrier(0); \
        P1_LDK(1, 8); P1_UPD(2, 4); __builtin_amdgcn_sched_barrier(0); \
        P1_LDK(2, 10); P1_UPD(0, 6); __builtin_amdgcn_sched_barrier(0); \
        P1_LDK(0, 12); P1_UPD(1, 8); __builtin_amdgcn_sched_barrier(0); \
        P1_LDK(1, 14); P1_UPD(2, 10); __builtin_amdgcn_sched_barrier(0); \
        P1_UPD(0, 12); P1_UPD(1, 14); \
        __syncthreads(); } while (0)
    P1_PREFETCH(pkA, pvA, 0); P1_PREFETCH(pkB, pvB, 1);
    for (int c = 0; c < RNCH; c += 2) { P1_CHUNK(pkA, pvA, c + 2); P1_CHUNK(pkB, pvB, c + 3); }
#undef P1_PREFETCH
#undef P1_LDK
#undef P1_UPD
#undef P1_CHUNK
    f32x4* Lp = (f32x4*)Lbuf + ((size_t)(((g * 8 + h) * 4 + vq) * 8 + wave) * 16) * 64 + lane;
#pragma unroll
    for (int dt = 0; dt < 16; ++dt) Lp[dt * 64] = st[dt];
}

__global__ void __launch_bounds__(512, 2) mk_fwd(Args a) {
    extern __shared__ __attribute__((aligned(16))) unsigned char lds_raw[];
    LAS unsigned char* lds = (LAS unsigned char*)lds_raw;
    const int tid = threadIdx.x, lane = tid & 63, wave = __builtin_amdgcn_readfirstlane(tid >> 6);
    const int G = gridDim.x, gw = blockIdx.x * 8 + wave, NGW = G * 8;
    unsigned char* ws = a.ws; unsigned char* dob = (unsigned char*)a.out;
    long long* modacc = (long long*)(ws + WS_CTL);
    bf16_t* WoutT = (bf16_t*)(ws + WS_WOUT); bf16_t* WqsT = (bf16_t*)(ws + WS_WQS); bf16_t* WinT = (bf16_t*)(ws + WS_WIN);
    bf16_t* pooled = (bf16_t*)(ws + WS_POOLED); bf16_t* upool = (bf16_t*)(ws + WS_UPOOL); bf16_t* merged = (bf16_t*)(ws + WS_MERGED);
    bf16_t* qb = (bf16_t*)(ws + WS_Q); bf16_t* kb = (bf16_t*)(ws + WS_K); bf16_t* vb = (bf16_t*)(ws + WS_V);
    unsigned char* utab = ws + WS_UTAB; unsigned char* vtab = ws + WS_VTAB;
    float* scores = (float*)(ws + WS_SCORES);
    unsigned char* gret = ws + WS_GRET; bf16_t* fn = (bf16_t*)(ws + WS_FN);
    unsigned char* ret8 = ws + WS_Q;
    unsigned char* fn8 = ws + WS_HN8;
    unsigned char* hn8 = ws + WS_HN8; unsigned char* WinT8 = ws + WS_WIN + (size_t)NB16 * D * 2;
    unsigned char* sap = ws + WS_SAP; unsigned char* sar = ws + WS_SAR;
    bf16_t* hn = (bf16_t*)(dob + DO_HN); float* rcos = (float*)(dob + DO_RCOS); float* rsin = (float*)(dob + DO_RSIN);
    float* Lbuf = (float*)(dob + DO_HN);
    bf16_t* WpcT = (bf16_t*)(dob + DO_WPC); bf16_t* PretT = (bf16_t*)(dob + DO_PRET);
    const int lo = a.ph_lo, hi = a.ph_hi;
#define IN(k) (lo <= (k) && (k) < hi)
#define PH_IDS const int lane = launder(lane_id()), tid = wave * 64 + lane
    volatile LAS unsigned* misc = (volatile LAS unsigned*)(lds + LDS_BYTES - 16);
    if (tid < 4) misc[tid] = 0u;
    __syncthreads();
    XcdBarrier xbar; xbar.bar = (unsigned*)(ws + WS_CTL + CTL_BAR); xbar.x = 0; xbar.st = misc; xbar.wave = wave;
    if (hi - lo > 1) xbar = xcd_barrier_post((unsigned*)(ws + WS_CTL + CTL_BAR), misc, wave);
#define SEAM(k) do { if (lo <= (k) && (k) + 1 < hi) xcd_barrier(xbar); } while (0)

    float* pscale = (float*)(ws + WS_CTL + CTL_SCALE);
    if (IN(0)) { PH_IDS;
        if (blockIdx.x == 0) {
            float su = 0.f, sv = 0.f;
#pragma unroll
            for (int q = 0; q < 8; ++q) { const f32x4 uq = *(const f32x4*)(a.peer_u + tid * 32 + 4 * q), vq = *(const f32x4*)(a.peer_v + tid * 32 + 4 * q);
                su += uq.x * uq.x + uq.y * uq.y + uq.z * uq.z + uq.w * uq.w; sv += vq.x * vq.x + vq.y * vq.y + vq.z * vq.z + vq.w * vq.w; }
            su = wave_sum(su); sv = wave_sum(sv);
            LAS float* red = (LAS float*)lds;
            if (lane == 0) { red[wave] = su; red[8 + wave] = sv; }
            __syncthreads();
            if (tid == 0) { float tu = 0.f, tv = 0.f; for (int w = 0; w < 8; ++w) { tu += red[w]; tv += red[8 + w]; }
                const float ru = sqrtf(tu * (1.0f / 16384.0f)) + 1e-30f, rv = sqrtf(tv * (1.0f / 16384.0f)) + 1e-30f;
                pscale[0] = 2.0f / ru; pscale[1] = 2.0f / rv; pscale[2] = ru * 0.5f; pscale[3] = rv * 0.5f; }
            __syncthreads();
        }
        LAS float* scr = (LAS float*)(lds + wave * 16384);
        volatile LAS int* wq = (volatile LAS int*)(lds + 8 * 16384);
        if (tid == 0) *wq = 0;
        __syncthreads();
        if (wave < 4) for (int it = blockIdx.x * 4 + wave; it < 1024; it += G * 4) {
            const int g = it >> 8, cb = (it >> 5) & 7, nb = it & 31, l15 = lane & 15, l4 = lane >> 4;
            f32x4 acc[4][4];
#pragma unroll
            for (int mi = 0; mi < 4; ++mi)
#pragma unroll
                for (int ni = 0; ni < 4; ++ni) acc[mi][ni] = (f32x4){0.f, 0.f, 0.f, 0.f};
            const float* pa = a.pool_w + ((size_t)g * 512 + cb * 64 + l15) * 512 + 8 * l4;
            const float* pb = a.w_branch_pool + (size_t)(g * 512 + 8 * l4) * D + nb * 64 + l15;
            const float* ps = a.pool_scale + g * 512 + 8 * l4;
#pragma unroll 2
            for (int d0 = 0; d0 < 512; d0 += 32) {
                bf16x8 af[4], bfr[4];
                const f32x4 s0 = *(const f32x4*)(ps + d0), s1 = *(const f32x4*)(ps + d0 + 4);
                float braw[4][8];
#pragma unroll
                for (int ni = 0; ni < 4; ++ni)
#pragma unroll
                    for (int e = 0; e < 8; ++e) braw[ni][e] = pb[(size_t)(d0 + e) * D + ni * 16];
#pragma unroll
                for (int mi = 0; mi < 4; ++mi) { const f32x4 x0 = *(const f32x4*)(pa + (size_t)mi * 16 * 512 + d0), x1 = *(const f32x4*)(pa + (size_t)mi * 16 * 512 + d0 + 4);
                    u32x4 w; w.x = pk2(x0.x, x0.y); w.y = pk2(x0.z, x0.w); w.z = pk2(x1.x, x1.y); w.w = pk2(x1.z, x1.w); af[mi] = __builtin_bit_cast(bf16x8, w); }
#pragma unroll
                for (int ni = 0; ni < 4; ++ni) { u32x4 w; w.x = pk2(braw[ni][0] * s0.x, braw[ni][1] * s0.y); w.y = pk2(braw[ni][2] * s0.z, braw[ni][3] * s0.w); w.z = pk2(braw[ni][4] * s1.x, braw[ni][5] * s1.y); w.w = pk2(braw[ni][6] * s1.z, braw[ni][7] * s1.w);
                    bfr[ni] = __builtin_bit_cast(bf16x8, w); }
#pragma unroll
                for (int mi = 0; mi < 4; ++mi)
#pragma unroll
                    for (int ni = 0; ni < 4; ++ni) acc[mi][ni] = __builtin_amdgcn_mfma_f32_16x16x32_bf16(af[mi], bfr[ni], acc[mi][ni], 0, 0, 0);
            }
#pragma unroll
            for (int mi = 0; mi < 4; ++mi)
#pragma unroll
                for (int ni = 0; ni < 4; ++ni) { u32x2 w; w.x = pk2(acc[mi][ni][0], acc[mi][ni][1]); w.y = pk2(acc[mi][ni][2], acc[mi][ni][3]);
                    *(u32x2*)(WpcT + (size_t)(nb * 64 + ni * 16 + l15) * D + g * 512 + cb * 64 + mi * 16 + 4 * l4) = w; }
        }
        if (wave < 4) for (int it = blockIdx.x * 4 + wave; it < 1024; it += G * 4) {
            const int hp = it >> 6, nb = (it >> 5) & 1, db = it & 31, l15 = lane & 15, l4 = lane >> 4;
            f32x4 acc[4][4];
#pragma unroll
            for (int mi = 0; mi < 4; ++mi)
#pragma unroll
                for (int ni = 0; ni < 4; ++ni) acc[mi][ni] = (f32x4){0.f, 0.f, 0.f, 0.f};
            const float* pa = a.peer_w_query + (size_t)(db * 64 + l15) * D + hp * 128 + 8 * l4;
            const float* pb = a.peer_sub_keys + ((size_t)hp * 128 + nb * 64 + l15) * 128 + 8 * l4;
#pragma unroll
            for (int c0 = 0; c0 < 128; c0 += 32) {
                bf16x8 af[4], bfr[4];
#pragma unroll
                for (int mi = 0; mi < 4; ++mi) { const f32x4 x0 = *(const f32x4*)(pa + (size_t)mi * 16 * D + c0), x1 = *(const f32x4*)(pa + (size_t)mi * 16 * D + c0 + 4);
                    u32x4 w; w.x = pk2(x0.x, x0.y); w.y = pk2(x0.z, x0.w); w.z = pk2(x1.x, x1.y); w.w = pk2(x1.z, x1.w); af[mi] = __builtin_bit_cast(bf16x8, w); }
#pragma unroll
                for (int ni = 0; ni < 4; ++ni) { const f32x4 x0 = *(const f32x4*)(pb + (size_t)ni * 16 * 128 + c0), x1 = *(const f32x4*)(pb + (size_t)ni * 16 * 128 + c0 + 4);
                    u32x4 w; w.x = pk2(x0.x, x0.y); w.y = pk2(x0.z, x0.w); w.z = pk2(x1.x, x1.y); w.w = pk2(x1.z, x1.w); bfr[ni] = __builtin_bit_cast(bf16x8, w); }
#pragma unroll
                for (int mi = 0; mi < 4; ++mi)
#pragma unroll
                    for (int ni = 0; ni < 4; ++ni) acc[mi][ni] = __builtin_amdgcn_mfma_f32_16x16x32_bf16(af[mi], bfr[ni], acc[mi][ni], 0, 0, 0);
            }
#pragma unroll
            for (int mi = 0; mi < 4; ++mi)
#pragma unroll
                for (int ni = 0; ni < 4; ++ni) { u32x2 w; w.x = pk2(acc[mi][ni][0], acc[mi][ni][1]); w.y = pk2(acc[mi][ni][2], acc[mi][ni][3]);
                    *(u32x2*)(WqsT + (size_t)(hp * 128 + nb * 64 + ni * 16 + l15) * D + db * 64 + mi * 16 + 4 * l4) = w; }
        }
        constexpr int I_IN = (D / 64) * (NIN / 32), I_PR = (VW / 64) * (D / 32), I_WO = (D / 64) * (D / 32);
        constexpr int NT_ITEMS = (I_IN + I_PR + I_WO) / 256, NG_ITEMS = 64 * 48 / 256;
        if (G == 256) {
            for (;;) {
                int n = 0;
                if (lane == 0) n = __hip_atomic_fetch_add((LAS int*)wq, 1, __ATOMIC_RELAXED, __HIP_MEMORY_SCOPE_WORKGROUP);
                n = __builtin_amdgcn_readfirstlane(n);
                if (n >= NT_ITEMS + NG_ITEMS) break;
                if (n < NT_ITEMS) {
                    int r = (int)blockIdx.x * 8 + (n & 7) + 2048 * (n >> 3);
                    if (r < I_IN) { transpose_item(a.w_in, D, NIN, WinT, scr, r, lane, NB16, WinT8); continue; } r -= I_IN;
                    if (r < I_PR) { transpose_item(a.w_branch_ret, VW, D, PretT, scr, r, lane, 0, (unsigned char*)PretT); continue; } r -= I_PR;
                    transpose_item(a.w_out, D, D, WoutT, scr, r, lane);
                } else {
                    const int it = (int)blockIdx.x + 256 * (n - NT_ITEMS);
                    const int kc = it / 48, nc = it % 48, k0 = kc * 32, nn = nc * 256 + lane * 4;
                    f32x4 acc = (f32x4){0.f, 0.f, 0.f, 0.f};
#pragma unroll
                    for (int kk = 0; kk < 32; ++kk) { const float cv = a.c[k0 + kk]; const float sv = cv * sigmoidf_(cv); acc += __builtin_nontemporal_load((const f32x4*)(a.w_ada + (size_t)(k0 + kk) * (6 * D) + nn)) * sv; }
#pragma unroll
                    for (int e = 0; e < 4; ++e) atomicAdd((unsigned long long*)(modacc + nn + e), (unsigned long long)(long long)__double2ll_rn((double)acc[e] * MOD_FX));
                }
            }
        } else
        for (int it = gw; it < I_IN + I_PR + I_WO; it += NGW) {
            int r = it;
            if (r < I_IN) { transpose_item(a.w_in, D, NIN, WinT, scr, r, lane, NB16, WinT8); continue; } r -= I_IN;
            if (r < I_PR) { transpose_item(a.w_branch_ret, VW, D, PretT, scr, r, lane, 0, (unsigned char*)PretT); continue; } r -= I_PR;
            transpose_item(a.w_out, D, D, WoutT, scr, r, lane);
        }
        const float rinv = powf(10000.0f, -(float)(2 * (tid & 127)) * (1.0f / 256.0f));
        for (int idx = blockIdx.x * 512 + tid; idx < S * 128; idx += G * 512) {
            const int t = idx >> 7;
            const float inv = rinv;
            const float ang = (float)a.positions[t] * inv;
            float sn, cs; sincosf(ang, &sn, &cs);
            rcos[idx] = cs; rsin[idx] = sn;
        }
        if (G != 256) for (int it = gw; it < 64 * 48; it += NGW) {
            const int kc = it / 48, nc = it % 48, k0 = kc * 32, n = nc * 256 + lane * 4;
            f32x4 acc = (f32x4){0.f, 0.f, 0.f, 0.f};
#pragma unroll
            for (int kk = 0; kk < 32; ++kk) { const float cv = a.c[k0 + kk]; const float sv = cv * sigmoidf_(cv); acc += *(const f32x4*)(a.w_ada + (size_t)(k0 + kk) * (6 * D) + n) * sv; }
#pragma unroll
            for (int e = 0; e < 4; ++e) atomicAdd((unsigned long long*)(modacc + n + e), (unsigned long long)(long long)__double2ll_rn((double)acc[e] * MOD_FX));
        }
    }
    SEAM(0);
    if (IN(1)) { PH_IDS;
        LAS float* ml = (LAS float*)lds;
        for (int i = launder(tid); i < 2 * D; i += 512) ml[i] = modval(modacc, a.b_ada, i);
        __syncthreads();
        for (int m = gw * 2; m < S; m += NGW * 2) norm_mod_row2<true>(a.x + (size_t)m * D, a.x + (size_t)(m + 1) * D, a.norm_mix_gain, ml, ml + D, hn + (size_t)m * D, hn + (size_t)(m + 1) * D, lane, hn8 + (size_t)m * D, hn8 + (size_t)(m + 1) * D);
    }
    SEAM(1);
    if (IN(2)) { PH_IDS;
        { pg8::Gemm g{hn, WinT, S, NB16, D}; pg8::StaticOrder so; so.init(S, NB16, G, (int)blockIdx.x);
          EpiG1<0> E{upool, qb, kb, vb, gret, sap, sar, rcos, rsin, 0};
          pg8::gemm_phase<EpiG1<0>>(lds, g, so, E, wave); }
        { pg8::Gemm g{(const bf16_t*)hn8, (const bf16_t*)WinT8, S, NIN - NB16, D}; pg8::StaticOrder so; so.init(S, NIN - NB16, G, (int)blockIdx.x);
          EpiG1<1> E{upool, qb, kb, vb, gret, sap, sar, rcos, rsin, NB16 / 256};
          pg8::gemm_phase<EpiG1<1>, true, true, true>(lds, g, so, E, wave); }
    }
    SEAM(2);
    if (IN(3)) { PH_IDS;
        for (int un = blockIdx.x; un < 256; un += G) ret_pass1(lds, kb, vb, Lbuf, un, tid, lane, wave);
        const bool skew = (G == 256); const bool idleb = (blockIdx.x & 7) == 7;
        const int wfirst = skew ? (idleb ? 5376 + ((int)(blockIdx.x >> 3) * 8 + wave) : (((int)(blockIdx.x >> 3) * 7 + (int)(blockIdx.x & 7)) * 8 + wave)) : gw;
        const int wstep = skew ? (idleb ? 256 : 1792) : NGW, wend = skew ? (idleb ? 8192 : 5376) : 8192;
        for (int wi = wfirst; wi < wend; wi += wstep) {
            const int idx = wi * 64 + lane;
            const int t0 = (idx >> 8) * 8, c8 = (idx & 255) * 8, grp = __builtin_amdgcn_readfirstlane(c8 >> 9);
            const bf16_t* up = upool + (size_t)t0 * 2048 + c8;
            bf16_t* op = pooled + (size_t)t0 * 2048 + c8;
#define POOL_W(W) do { u32x4 uv[W + 7]; _Pragma("unroll") for (int j = 0; j < W + 7; ++j) { const int tt = t0 - (W - 1) + j; uv[j] = (tt >= 0) ? *(const u32x4*)(up + ((long)j - (W - 1)) * 2048) : (u32x4){0u, 0u, 0u, 0u}; } \
                float sm[8]; _Pragma("unroll") for (int e = 0; e < 8; ++e) sm[e] = 0.f; \
                _Pragma("unroll") for (int j = 0; j < W - 1; ++j) { sm[0] += bf_lo(uv[j].x); sm[1] += bf_hi(uv[j].x); sm[2] += bf_lo(uv[j].y); sm[3] += bf_hi(uv[j].y); sm[4] += bf_lo(uv[j].z); sm[5] += bf_hi(uv[j].z); sm[6] += bf_lo(uv[j].w); sm[7] += bf_hi(uv[j].w); } \
                _Pragma("unroll") for (int i = 0; i < 8; ++i) { const u32x4 cu = uv[W - 1 + i]; \
                    const float cf[8] = {bf_lo(cu.x), bf_hi(cu.x), bf_lo(cu.y), bf_hi(cu.y), bf_lo(cu.z), bf_hi(cu.z), bf_lo(cu.w), bf_hi(cu.w)}; \
                    _Pragma("unroll") for (int e = 0; e < 8; ++e) sm[e] += cf[e]; \
                    const int cnt = (t0 + i + 1 < W) ? (t0 + i + 1) : W; const float inv = 1.0f / (float)cnt; \
                    u32x4 o; o.x = pk2(sm[0] * inv - cf[0], sm[1] * inv - cf[1]); o.y = pk2(sm[2] * inv - cf[2], sm[3] * inv - cf[3]); o.z = pk2(sm[4] * inv - cf[4], sm[5] * inv - cf[5]); o.w = pk2(sm[6] * inv - cf[6], sm[7] * inv - cf[7]); \
                    *(u32x4*)(op + (size_t)i * 2048) = o; \
                    const u32x4 ou = uv[i]; sm[0] -= bf_lo(ou.x); sm[1] -= bf_hi(ou.x); sm[2] -= bf_lo(ou.y); sm[3] -= bf_hi(ou.y); sm[4] -= bf_lo(ou.z); sm[5] -= bf_hi(ou.z); sm[6] -= bf_lo(ou.w); sm[7] -= bf_hi(ou.w); } } while (0)
            if (grp == 0) POOL_W(2); else if (grp == 1) POOL_W(4); else if (grp == 2) POOL_W(8); else POOL_W(16);
#undef POOL_W
        }
    }
    SEAM(3);
    if (IN(4)) { PH_IDS;
        const float tsu = pscale[0], tsv = pscale[1];
        int tjp = gw;
        for (int un = blockIdx.x; un < 256; un += G) tjp = ret_pass<true>(lds, qb, kb, vb, Lbuf, un, tid, lane, wave, a.peer_u, a.peer_v, utab, vtab, tsu, tsv, tjp, NGW);
    }
    SEAM(4);
    if (IN(5)) { PH_IDS;
        const bool ln_first = (blockIdx.x & 1) != 0;
        if (ln_first) {
        for (int un0 = gw * 4; un0 < S * RH; un0 += NGW * 4) {
            u32x4 yv[4]; u32x2 gv[4];
#pragma unroll
            for (int q = 0; q < 4; ++q) { const int un = un0 + q; const size_t off = (size_t)(un >> 3) * 4096 + (un & 7) * 512 + 8 * lane; yv[q] = __builtin_nontemporal_load((const u32x4*)(vb + off)); gv[q] = __builtin_nontemporal_load((const u32x2*)(gret + off)); }
#pragma unroll
            for (int q = 0; q < 4; ++q) {
                const int un = un0 + q, h = un & 7;
                float y[8] = {bf_lo(yv[q].x), bf_hi(yv[q].x), bf_lo(yv[q].y), bf_hi(yv[q].y), bf_lo(yv[q].z), bf_hi(yv[q].z), bf_lo(yv[q].w), bf_hi(yv[q].w)};
                float s1 = 0.f;
#pragma unroll
                for (int e = 0; e < 8; ++e) s1 += y[e];
                const float mean = wave_sum(s1) * (1.0f / 512.0f);
                float s2 = 0.f;
#pragma unroll
                for (int e = 0; e < 8; ++e) { y[e] -= mean; s2 += y[e] * y[e]; }
                const float rstd = 1.0f / sqrtf(wave_sum(s2) * (1.0f / 512.0f) + EPS);
                const f32x2 ga = __builtin_amdgcn_cvt_pk_f32_fp8((int)gv[q].x, false), gb = __builtin_amdgcn_cvt_pk_f32_fp8((int)gv[q].x, true), gc = __builtin_amdgcn_cvt_pk_f32_fp8((int)gv[q].y, false), gd = __builtin_amdgcn_cvt_pk_f32_fp8((int)gv[q].y, true);
                const float gg[8] = {ga.x, ga.y, gb.x, gb.y, gc.x, gc.y, gd.x, gd.y};
                const f32x4 n0 = *(const f32x4*)(a.ret_norm_gain + h * 512 + 8 * lane), n1 = *(const f32x4*)(a.ret_norm_gain + h * 512 + 8 * lane + 4);
                const float nn[8] = {n0.x, n0.y, n0.z, n0.w, n1.x, n1.y, n1.z, n1.w};
                float o[8];
#pragma unroll
                for (int e = 0; e < 8; ++e) o[e] = y[e] * rstd * nn[e] * gg[e];
                int w0 = __builtin_amdgcn_cvt_pk_fp8_f32(o[0] * 8.0f, o[1] * 8.0f, 0, false); w0 = __builtin_amdgcn_cvt_pk_fp8_f32(o[2] * 8.0f, o[3] * 8.0f, w0, true);
                int w1 = __builtin_amdgcn_cvt_pk_fp8_f32(o[4] * 8.0f, o[5] * 8.0f, 0, false); w1 = __builtin_amdgcn_cvt_pk_fp8_f32(o[6] * 8.0f, o[7] * 8.0f, w1, true);
                u32x2 w; w.x = (unsigned)w0; w.y = (unsigned)w1;
                *(u32x2*)(ret8 + (size_t)(un >> 3) * 4096 + h * 512 + 8 * lane) = w;
            }
        }
        }
        { pg8::Gemm g{pooled, WpcT, S, D, D}; pg8::StaticOrder so; so.init(S, D, G, (int)blockIdx.x);
          EpiGate<0> E{sap, merged}; pg8::gemm_phase<EpiGate<0>>(lds, g, so, E, wave); }
        if (!ln_first) {
        for (int un0 = gw * 4; un0 < S * RH; un0 += NGW * 4) {
            u32x4 yv[4]; u32x2 gv[4];
#pragma unroll
            for (int q = 0; q < 4; ++q) { const int un = un0 + q; const size_t off = (size_t)(un >> 3) * 4096 + (un & 7) * 512 + 8 * lane; yv[q] = __builtin_nontemporal_load((const u32x4*)(vb + off)); gv[q] = __builtin_nontemporal_load((const u32x2*)(gret + off)); }
#pragma unroll
            for (int q = 0; q < 4; ++q) {
                const int un = un0 + q, h = un & 7;
                float y[8] = {bf_lo(yv[q].x), bf_hi(yv[q].x), bf_lo(yv[q].y), bf_hi(yv[q].y), bf_lo(yv[q].z), bf_hi(yv[q].z), bf_lo(yv[q].w), bf_hi(yv[q].w)};
                float s1 = 0.f;
#pragma unroll
                for (int e = 0; e < 8; ++e) s1 += y[e];
                const float mean = wave_sum(s1) * (1.0f / 512.0f);
                float s2 = 0.f;
#pragma unroll
                for (int e = 0; e < 8; ++e) { y[e] -= mean; s2 += y[e] * y[e]; }
                const float rstd = 1.0f / sqrtf(wave_sum(s2) * (1.0f / 512.0f) + EPS);
                const f32x2 ga = __builtin_amdgcn_cvt_pk_f32_fp8((int)gv[q].x, false), gb = __builtin_amdgcn_cvt_pk_f32_fp8((int)gv[q].x, true), gc = __builtin_amdgcn_cvt_pk_f32_fp8((int)gv[q].y, false), gd = __builtin_amdgcn_cvt_pk_f32_fp8((int)gv[q].y, true);
                const float gg[8] = {ga.x, ga.y, gb.x, gb.y, gc.x, gc.y, gd.x, gd.y};
                const f32x4 n0 = *(const f32x4*)(a.ret_norm_gain + h * 512 + 8 * lane), n1 = *(const f32x4*)(a.ret_norm_gain + h * 512 + 8 * lane + 4);
                const float nn[8] = {n0.x, n0.y, n0.z, n0.w, n1.x, n1.y, n1.z, n1.w};
                float o[8];
#pragma unroll
                for (int e = 0; e < 8; ++e) o[e] = y[e] * rstd * nn[e] * gg[e];
                int w0 = __builtin_amdgcn_cvt_pk_fp8_f32(o[0] * 8.0f, o[1] * 8.0f, 0, false); w0 = __builtin_amdgcn_cvt_pk_fp8_f32(o[2] * 8.0f, o[3] * 8.0f, w0, true);
                int w1 = __builtin_amdgcn_cvt_pk_fp8_f32(o[4] * 8.0f, o[5] * 8.0f, 0, false); w1 = __builtin_amdgcn_cvt_pk_fp8_f32(o[6] * 8.0f, o[7] * 8.0f, w1, true);
                u32x2 w; w.x = (unsigned)w0; w.y = (unsigned)w1;
                *(u32x2*)(ret8 + (size_t)(un >> 3) * 4096 + h * 512 + 8 * lane) = w;
            }
        }
        }
    }
    SEAM(5);
    if (IN(6)) { PH_IDS;
        { pg8::Gemm g{(const bf16_t*)ret8, PretT, S, D, VW}; pg8::StaticOrder so; so.init(S, D, G, (int)blockIdx.x);
          EpiGate<1> E{sar, merged}; pg8::gemm_phase<EpiGate<1>, true, true, true>(lds, g, so, E, wave); }
    }
    SEAM(6);
    if (IN(7)) { PH_IDS;
        pg8::Gemm g{merged, WoutT, S, D, D}; pg8::StaticOrder so; so.init(S, D, G, (int)blockIdx.x);
        EpiRes E{a.x, a.out, modacc, a.b_ada}; pg8::gemm_phase<EpiRes>(lds, g, so, E, wave);
    }
    SEAM(7);
    if (IN(8)) { PH_IDS;
        LAS float* ml = (LAS float*)lds;
        for (int i = launder(tid); i < 2 * D; i += 512) ml[i] = modval(modacc, a.b_ada, 3 * D + i);
        __syncthreads();
        for (int m = gw * 2; m < S; m += NGW * 2) norm_mod_row2<(PEER_UMFMA != 0)>(a.out + (size_t)m * D, a.out + (size_t)(m + 1) * D, a.norm_ffn_gain, ml, ml + D, fn + (size_t)m * D, fn + (size_t)(m + 1) * D, lane, fn8 + (size_t)m * D, fn8 + (size_t)(m + 1) * D);
#if TAB_IN_RET
        for (int p = gw + NGW * ((((int)blockIdx.x < 256) ? (255 - (int)blockIdx.x) / G + 1 : 0) * RNCH); p < NHP; p += NGW) {
            const float* src = tab_src(a.peer_u, a.peer_v, p) + 16 * lane;
            f32x4 xv[4];
#pragma unroll
            for (int q = 0; q < 4; ++q) xv[q] = *(const f32x4*)(src + 4 * q);
            tab4_half_store(xv, pscale[(p >= 2 * NE) ? 1 : 0], tab_dst(utab, vtab, p) + 8 * lane);
        }
#endif
        for (int pk = gw; pk < (TAB_IN_RET ? 0 : NE * 2); pk += NGW) {
            const int row = pk >> 1, isv = pk & 1; const float* src = (isv ? a.peer_v : a.peer_u) + (size_t)row * D + 32 * lane; const float scl = pscale[isv];
            const bool f4 = isv ? (PEER_VFP4 != 0) : (PEER_UFP4 != 0);
            f32x4 xv[8];
#pragma unroll
            for (int q = 0; q < 8; ++q) xv[q] = *(const f32x4*)(src + 4 * q);
            if (f4) {
                unsigned char* dst = (isv ? vtab : utab) + (size_t)row * 1024 + 16 * lane;
                unsigned w[4] = {0u, 0u, 0u, 0u};
#pragma unroll
                for (int i = 0; i < 32; ++i) {
                    const float v = xv[i >> 2][i & 3] * scl; const float m = fminf(fabsf(v), 6.0f);
                    const float cf = (m < 2.0f) ? rintf(m * 2.0f) : ((m < 4.0f) ? 2.0f + rintf(m) : 4.0f + rintf(m * 0.5f));
                    const unsigned code = (unsigned)(int)cf | ((v < 0.0f) ? 8u : 0u);
                    w[i >> 3] |= code << (4 * (i & 7));
                }
                u32x4 o; o.x = w[0]; o.y = w[1]; o.z = w[2]; o.w = w[3]; *(u32x4*)dst = o;
            } else {
                unsigned char* dst = (isv ? vtab : utab) + (size_t)row * 1536 + 8 * lane;
                unsigned w[6] = {0u, 0u, 0u, 0u, 0u, 0u};
#pragma unroll
                for (int i = 0; i < 32; ++i) {
                    const float v = xv[i >> 2][i & 3] * scl; const float m = fminf(fabsf(v), 7.5f);
                    const float cf = (m < 2.0f) ? rintf(m * 8.0f) : ((m < 4.0f) ? 8.0f + rintf(m * 4.0f) : 16.0f + rintf(m * 2.0f));
                    const unsigned code = (unsigned)(int)cf | ((v < 0.0f) ? 32u : 0u);
                    const int pos = 6 * i, d = pos >> 5, sh = pos & 31;
                    w[d] |= code << sh;
                    if (sh > 26) w[d + 1] |= code >> (32 - sh);
                }
                u32x2 o; o.x = w[0]; o.y = w[1]; *(u32x2*)dst = o; o.x = w[2]; o.y = w[3]; *(u32x2*)(dst + 512) = o; o.x = w[4]; o.y = w[5]; *(u32x2*)(dst + 1024) = o;
            }
        }
    }
    SEAM(8);
    if (IN(9)) { PH_IDS;
        pg8::Gemm g{fn, WqsT, S, D, D}; pg8::StaticOrder so; so.init(S, D, G, (int)blockIdx.x);
        EpiBf16Plain E{(bf16_t*)scores}; pg8::gemm_phase<EpiBf16Plain>(lds, g, so, E, wave);
    }
    SEAM(9);
    if (IN(10)) { PH_IDS;
        LAS int* keys = (LAS int*)(lds + wave * 16384);
        LAS int* exl = (LAS int*)(lds + wave * 16384 + 8192);
        LAS float* gtl = (LAS float*)(lds + wave * 16384 + 12288);
        LAS float* g2l = (LAS float*)(lds + 131072);
        const float uinv = pscale[2], vinv = pscale[3];
        for (int i = launder(tid); i < D; i += 512) g2l[(((i & 31) >> 2) * 64 + (i >> 5)) * 4 + (i & 3)] = modval(modacc, a.b_ada, 5 * D + i);
        __syncthreads();
#define INS16(arr, xin) do { int x_ = (xin); _Pragma("unroll") for (int p_ = 0; p_ < 16; ++p_) { const int hi_ = arr[p_] > x_ ? arr[p_] : x_; x_ = arr[p_] > x_ ? x_ : arr[p_]; arr[p_] = hi_; } } while (0)
        for (int wt = gw; wt < S / 8; wt += NGW) {
            {
                const int tl = lane >> 3, hh = lane & 7;
                const bf16_t* sp = (const bf16_t*)scores + (size_t)(wt * 8 + tl) * 2048 + hh * 256;
                int tv0[16], tv1[16];
#pragma unroll
                for (int p_ = 0; p_ < 16; ++p_) { tv0[p_] = (int)0x80000000; tv1[p_] = (int)0x80000000; }
#pragma unroll 1
                for (int i8 = 0; i8 < 16; ++i8) {
                    const u32x4 w0 = __builtin_nontemporal_load((const u32x4*)(sp + 8 * i8)), w1 = __builtin_nontemporal_load((const u32x4*)(sp + 128 + 8 * i8));
                    const float v0[8] = {bf_lo(w0.x), bf_hi(w0.x), bf_lo(w0.y), bf_hi(w0.y), bf_lo(w0.z), bf_hi(w0.z), bf_lo(w0.w), bf_hi(w0.w)};
                    const float v1[8] = {bf_lo(w1.x), bf_hi(w1.x), bf_lo(w1.y), bf_hi(w1.y), bf_lo(w1.z), bf_hi(w1.z), bf_lo(w1.w), bf_hi(w1.w)};
#pragma unroll
                    for (int e = 0; e < 8; ++e) {
                        const int tag = 127 - (8 * i8 + e);
                        INS16(tv0, (okey(v0[e]) & ~127) | tag);
                        INS16(tv1, (okey(v1[e]) & ~127) | tag);
                    }
                }
                float fv0[16], fv1[16];
#pragma unroll
                for (int p_ = 0; p_ < 16; ++p_) { fv0[p_] = okey_inv(tv0[p_] & ~127); fv1[p_] = okey_inv(tv1[p_] & ~127); keys[p_ * 64 + lane] = tv0[p_]; keys[(16 + p_) * 64 + lane] = tv1[p_]; }
                int best[16];
#pragma unroll
                for (int p_ = 0; p_ < 16; ++p_) best[p_] = (int)0x80000000;
#pragma unroll
                for (int ca = 0; ca < 16; ++ca)
#pragma unroll
                    for (int cb = 0; cb < 16; ++cb)
                        if ((ca + 1) * (cb + 1) <= 16) INS16(best, (okey(fv0[ca] + fv1[cb]) & ~255) | (255 - (ca * 16 + cb)));
                float ev[16]; float den = 0.f;
                const float mx = okey_inv(best[0] & ~255);
#pragma unroll
                for (int r = 0; r < 16; ++r) { ev[r] = __expf(okey_inv(best[r] & ~255) - mx); den += ev[r]; }
                const float inv = 1.0f / den;
                LDS_WAIT();
#pragma unroll
                for (int r = 0; r < 16; ++r) {
                    const int code = 255 - (best[r] & 255);
                    const int k0 = keys[(code >> 4) * 64 + lane], k1 = keys[(16 + (code & 15)) * 64 + lane];
                    exl[tl * 128 + hh * 16 + r] = (127 - (k0 & 127)) * 128 + (127 - (k1 & 127));
                    gtl[tl * 128 + hh * 16 + r] = ev[r] * inv;
                }
                LDS_WAIT();
            }
            LAS float* dots = (LAS float*)keys;
            for (int tl = 0; tl < 8; ++tl) {
                const int t = wt * 8 + tl;
                const LAS int* ex = exl + tl * 128; LAS float* gt = gtl + tl * 128;
                float xr[32];
#pragma unroll
                for (int q = 0; q < 4; ++q) { const u32x4 w = __builtin_nontemporal_load((const u32x4*)(fn + (size_t)t * 2048 + 32 * lane + 8 * q));
                    xr[8 * q + 0] = bf_lo(w.x); xr[8 * q + 1] = bf_hi(w.x); xr[8 * q + 2] = bf_lo(w.y); xr[8 * q + 3] = bf_hi(w.y); xr[8 * q + 4] = bf_lo(w.z); xr[8 * q + 5] = bf_hi(w.z); xr[8 * q + 6] = bf_lo(w.w); xr[8 * q + 7] = bf_hi(w.w); }
#if PEER_F16
                h16x2 xh[16];
#pragma unroll
                for (int m = 0; m < 16; ++m) xh[m] = __builtin_convertvector((f32x2){xr[2 * m], xr[2 * m + 1]}, h16x2);
#endif
#define ISSUE6(buf, tab, k0) do { _Pragma("unroll") for (int i_ = 0; i_ < 4; ++i_) { const int e_ = __builtin_amdgcn_readfirstlane(ex[(k0) + i_]); \
                    const unsigned char* rp_ = (tab) + (size_t)e_ * 1536 + 8 * lane; buf[i_][0] = *(const u32x2*)rp_; buf[i_][1] = *(const u32x2*)(rp_ + 512); buf[i_][2] = *(const u32x2*)(rp_ + 1024); } } while (0)
#define ISSUE4(buf, tab, k0) do { _Pragma("unroll") for (int i_ = 0; i_ < 4; ++i_) { const int e_ = __builtin_amdgcn_readfirstlane(ex[(k0) + i_]); \
                    buf[i_] = *(const u32x4*)((tab) + (size_t)e_ * 1024 + 16 * lane); } } while (0)
#define CVT6(buf, i_) __builtin_amdgcn_cvt_scalef32_pk32_f32_fp6((u32x6){buf[i_][0].x, buf[i_][0].y, buf[i_][1].x, buf[i_][1].y, buf[i_][2].x, buf[i_][2].y}, 1.0f)
#define ROWDOT6(buf, i_, res) do { const f32x32 v_ = CVT6(buf, i_); float a0_ = 0.f, a1_ = 0.f; \
                    _Pragma("unroll") for (int m_ = 0; m_ < 32; m_ += 2) { a0_ += v_[m_] * xr[m_]; a1_ += v_[m_ + 1] * xr[m_ + 1]; } res = a0_ + a1_; } while (0)
#define ROWDOT4(buf, i_, res) do { float a0_ = 0.f, a1_ = 0.f; \
                    _Pragma("unroll") for (int q_ = 0; q_ < 4; ++q_) { const unsigned w_ = buf[i_][q_]; \
                        { const f32x2 p_ = __builtin_amdgcn_cvt_scalef32_pk_f32_fp4(w_, 1.0f, 0); a0_ += p_.x * xr[8 * q_ + 0]; a1_ += p_.y * xr[8 * q_ + 1]; } \
                        { const f32x2 p_ = __builtin_amdgcn_cvt_scalef32_pk_f32_fp4(w_, 1.0f, 1); a0_ += p_.x * xr[8 * q_ + 2]; a1_ += p_.y * xr[8 * q_ + 3]; } \
                        { const f32x2 p_ = __builtin_amdgcn_cvt_scalef32_pk_f32_fp4(w_, 1.0f, 2); a0_ += p_.x * xr[8 * q_ + 4]; a1_ += p_.y * xr[8 * q_ + 5]; } \
                        { const f32x2 p_ = __builtin_amdgcn_cvt_scalef32_pk_f32_fp4(w_, 1.0f, 3); a0_ += p_.x * xr[8 * q_ + 6]; a1_ += p_.y * xr[8 * q_ + 7]; } } res = a0_ + a1_; } while (0)
#define ROWAXPY6(buf, i_, cf_) do { const f32x32 v_ = CVT6(buf, i_); _Pragma("unroll") for (int m_ = 0; m_ < 32; ++m_) oa[m_] += v_[m_] * cf_; } while (0)
#define ROWAXPY4(buf, i_, cf_) do { _Pragma("unroll") for (int q_ = 0; q_ < 4; ++q_) { const unsigned w_ = buf[i_][q_]; \
                        { const f32x2 p_ = __builtin_amdgcn_cvt_scalef32_pk_f32_fp4(w_, 1.0f, 0); oa[8 * q_ + 0] += p_.x * cf_; oa[8 * q_ + 1] += p_.y * cf_; } \
                        { const f32x2 p_ = __builtin_amdgcn_cvt_scalef32_pk_f32_fp4(w_, 1.0f, 1); oa[8 * q_ + 2] += p_.x * cf_; oa[8 * q_ + 3] += p_.y * cf_; } \
                        { const f32x2 p_ = __builtin_amdgcn_cvt_scalef32_pk_f32_fp4(w_, 1.0f, 2); oa[8 * q_ + 4] += p_.x * cf_; oa[8 * q_ + 5] += p_.y * cf_; } \
                        { const f32x2 p_ = __builtin_amdgcn_cvt_scalef32_pk_f32_fp4(w_, 1.0f, 3); oa[8 * q_ + 6] += p_.x * cf_; oa[8 * q_ + 7] += p_.y * cf_; } } } while (0)
#if PEER_F16
#define CVT6H(buf, i_) __builtin_amdgcn_cvt_scalef32_pk32_f16_fp6((u32x6){buf[i_][0].x, buf[i_][0].y, buf[i_][1].x, buf[i_][1].y, buf[i_][2].x, buf[i_][2].y}, 1.0f)
#define H2AT(v_, m_) ((h16x2){(v_)[2 * (m_)], (v_)[2 * (m_) + 1]})
#undef ROWDOT6
#undef ROWDOT4
#undef ROWAXPY6
#undef ROWAXPY4
#define ROWDOT6(buf, i_, res) do { const h16x32 v_ = CVT6H(buf, i_); float a0_ = 0.f, a1_ = 0.f; \
                    _Pragma("unroll") for (int m_ = 0; m_ < 16; m_ += 2) { a0_ = __builtin_amdgcn_fdot2(H2AT(v_, m_), xh[m_], a0_, false); a1_ = __builtin_amdgcn_fdot2(H2AT(v_, m_ + 1), xh[m_ + 1], a1_, false); } res = a0_ + a1_; } while (0)
#define ROWDOT4(buf, i_, res) do { float a0_ = 0.f, a1_ = 0.f; \
                    _Pragma("unroll") for (int q_ = 0; q_ < 4; ++q_) { const unsigned w_ = buf[i_][q_]; \
                        a0_ = __builtin_amdgcn_fdot2(__builtin_amdgcn_cvt_scalef32_pk_f16_fp4(w_, 1.0f, 0), xh[4 * q_ + 0], a0_, false); a1_ = __builtin_amdgcn_fdot2(__builtin_amdgcn_cvt_scalef32_pk_f16_fp4(w_, 1.0f, 1), xh[4 * q_ + 1], a1_, false); \
                        a0_ = __builtin_amdgcn_fdot2(__builtin_amdgcn_cvt_scalef32_pk_f16_fp4(w_, 1.0f, 2), xh[4 * q_ + 2], a0_, false); a1_ = __builtin_amdgcn_fdot2(__builtin_amdgcn_cvt_scalef32_pk_f16_fp4(w_, 1.0f, 3), xh[4 * q_ + 3], a1_, false); } res = a0_ + a1_; } while (0)
#define ROWAXPY6(buf, i_, cf_) do { const h16x32 v_ = CVT6H(buf, i_); const h16x2 c2_ = {(_Float16)(cf_), (_Float16)(cf_)}; \
                    _Pragma("unroll") for (int m_ = 0; m_ < 16; ++m_) oh[m_] = H2AT(v_, m_) * c2_ + oh[m_]; } while (0)
#define ROWAXPY4(buf, i_, cf_) do { const h16x2 c2_ = {(_Float16)(cf_), (_Float16)(cf_)}; \
                    _Pragma("unroll") for (int q_ = 0; q_ < 4; ++q_) { const unsigned w_ = buf[i_][q_]; \
                        oh[4 * q_ + 0] = __builtin_amdgcn_cvt_scalef32_pk_f16_fp4(w_, 1.0f, 0) * c2_ + oh[4 * q_ + 0]; oh[4 * q_ + 1] = __builtin_amdgcn_cvt_scalef32_pk_f16_fp4(w_, 1.0f, 1) * c2_ + oh[4 * q_ + 1]; \
                        oh[4 * q_ + 2] = __builtin_amdgcn_cvt_scalef32_pk_f16_fp4(w_, 1.0f, 2) * c2_ + oh[4 * q_ + 2]; oh[4 * q_ + 3] = __builtin_amdgcn_cvt_scalef32_pk_f16_fp4(w_, 1.0f, 3) * c2_ + oh[4 * q_ + 3]; } } while (0)
#endif
#if PEER_UFP4
                u32x4 ua[4], ub[4], uc[4];
#define U_ISSUE ISSUE4
#define U_ROWDOT ROWDOT4
#else
                u32x2 ua[4][3], ub[4][3], uc[4][3];
#define U_ISSUE ISSUE6
#define U_ROWDOT ROWDOT6
#endif
#if PEER_VFP4
                u32x4 va[4], vbb[4], vc[4];
#define V_ISSUE ISSUE4
#define V_ROWAXPY ROWAXPY4
#else
                u32x2 va[4][3], vbb[4][3], vc[4][3];
#define V_ISSUE ISSUE6
#define V_ROWAXPY ROWAXPY6
#endif
#define PEER_DOT(buf, k0) do { float d_[4]; _Pragma("unroll") for (int i_ = 0; i_ < 4; ++i_) U_ROWDOT(buf, i_, d_[i_]); \
                    const bool b5_ = lane & 32, b4_ = lane & 16; float k1_[2], k2_; \
                    _Pragma("unroll") for (int c_ = 0; c_ < 2; ++c_) { const float snd_ = b5_ ? d_[c_] : d_[c_ + 2]; const float rcv_ = __shfl_xor(snd_, 32); k1_[c_] = (b5_ ? d_[c_ + 2] : d_[c_]) + rcv_; } \
                    { const float snd_ = b4_ ? k1_[0] : k1_[1]; const float rcv_ = __shfl_xor(snd_, 16); k2_ = (b4_ ? k1_[1] : k1_[0]) + rcv_; } \
                    k2_ += __shfl_xor(k2_, 8); k2_ += __shfl_xor(k2_, 4); k2_ += __shfl_xor(k2_, 2); k2_ += __shfl_xor(k2_, 1); \
                    if ((lane & 15) == 0) dots[(k0) + (b5_ ? 2 : 0) + (b4_ ? 1 : 0)] = k2_; } while (0)
#define PEER_AXPY(buf, k0) do { _Pragma("unroll") for (int i_ = 0; i_ < 4; ++i_) { const float cf_ = gt[(k0) + i_]; V_ROWAXPY(buf, i_, cf_); } } while (0)
#if PEER_UMFMA && PEER_UFP4
                {
                    const int r16 = lane & 15, kb = lane >> 4;
                    unsigned eoff[8];
#pragma unroll
                    for (int tile = 0; tile < 8; ++tile) eoff[tile] = (unsigned)ex[tile * 16 + r16] * 1024u + 16u * (unsigned)kb;
                    LAS unsigned char* f8l = (LAS unsigned char*)keys + 4096;
                    { const pg8::i32x4_t f0_ = *(const pg8::i32x4_t*)(fn8 + (size_t)t * 2048 + 32 * lane), f1_ = *(const pg8::i32x4_t*)(fn8 + (size_t)t * 2048 + 32 * lane + 16);
                      *(LAS pg8::i32x4_t*)(f8l + 32 * lane) = f0_; *(LAS pg8::i32x4_t*)(f8l + 32 * lane + 16) = f1_; }
                    LDS_WAIT();
                    const LAS unsigned char* f8 = f8l + 16 * kb;
#define ULOAD2(A0, A1, sidx, tb) do { const unsigned char* ul_ = utab + 64 * (sidx); _Pragma("unroll") for (int q_ = 0; q_ < 4; ++q_) { \
                        A0[q_] = *(const pg8::i32x4_t*)(ul_ + eoff[(tb) + q_]); A1[q_] = *(const pg8::i32x4_t*)(ul_ + 64 + eoff[(tb) + q_]); } } while (0)
#define UMMA4(AB, sidx) do { const pg8::i32x4_t b0_ = *(const LAS pg8::i32x4_t*)(f8 + 128 * (sidx)), b1_ = *(const LAS pg8::i32x4_t*)(f8 + 128 * (sidx) + 64); \
                        const pg8::i32x8_t B8_ = __builtin_shufflevector(b0_, b1_, 0, 1, 2, 3, 4, 5, 6, 7); \
                        _Pragma("unroll") for (int q_ = 0; q_ < 4; ++q_) { const pg8::i32x4_t a4_ = AB[q_]; const pg8::i32x8_t A8_ = {a4_.x, a4_.y, a4_.z, a4_.w, 0, 0, 0, 0}; \
                            uacc[q_] = __builtin_amdgcn_mfma_scale_f32_16x16x128_f8f6f4(A8_, B8_, uacc[q_], 4, 0, 0, 0x7F7F7F7F, 0, 0x7C7C7C7C); } } while (0)
#pragma unroll 1
                    for (int tb_ = 0; tb_ < 8; tb_ += 4) {
                        f32x4 uacc[4];
#pragma unroll
                        for (int q_ = 0; q_ < 4; ++q_) uacc[q_] = (f32x4){0.f, 0.f, 0.f, 0.f};
                        pg8::i32x4_t pa0[4], pa1[4], pb0[4], pb1[4];
                        unsigned eo_[4];
#pragma unroll
                        for (int q_ = 0; q_ < 4; ++q_) eo_[q_] = tb_ ? eoff[4 + q_] : eoff[q_];
#define ULOADP(A0, A1, sidx) do { const unsigned char* ul_ = utab + 64 * (sidx); _Pragma("unroll") for (int q_ = 0; q_ < 4; ++q_) { \
                            A0[q_] = *(const pg8::i32x4_t*)(ul_ + eo_[q_]); A1[q_] = *(const pg8::i32x4_t*)(ul_ + 64 + eo_[q_]); } } while (0)
                        ULOADP(pa0, pa1, 0);
#pragma unroll 1
                        for (int sp_ = 0; sp_ < 16; sp_ += 4) {
                            ULOADP(pb0, pb1, sp_ + 2);
                            UMMA4(pa0, sp_); UMMA4(pa1, sp_ + 1); __builtin_amdgcn_sched_barrier(0);
                            if (sp_ + 4 < 16) ULOADP(pa0, pa1, sp_ + 4);
                            UMMA4(pb0, sp_ + 2); UMMA4(pb1, sp_ + 3); __builtin_amdgcn_sched_barrier(0);
                        }
#undef ULOADP
                        if (r16 == 0) {
#pragma unroll
                            for (int q_ = 0; q_ < 4; ++q_) *(LAS f32x4*)(dots + (tb_ + q_) * 16 + 4 * kb) = uacc[q_];
                        }
                    }
#undef ULOAD2
#undef UMMA4

                }
#elif PEER_DEPTH3
                U_ISSUE(ua, utab, 0); U_ISSUE(ub, utab, 4);
#pragma unroll 1
                for (int k0 = 0; k0 < 120; k0 += 12) {
                    U_ISSUE(uc, utab, k0 + 8);
                    PEER_DOT(ua, k0);
                    U_ISSUE(ua, utab, k0 + 12);
                    PEER_DOT(ub, k0 + 4);
                    U_ISSUE(ub, utab, k0 + 16);
                    PEER_DOT(uc, k0 + 8);
                }
                PEER_DOT(ua, 120); PEER_DOT(ub, 124);
#else
                U_ISSUE(ua, utab, 0);
#pragma unroll 1
                for (int k0 = 0; k0 < 128; k0 += 8) {
                    U_ISSUE(ub, utab, k0 + 4);
                    PEER_DOT(ua, k0);
                    if (k0 + 8 < 128) U_ISSUE(ua, utab, k0 + 8);
                    PEER_DOT(ub, k0 + 4);
                }
#endif
                LDS_WAIT();
#pragma unroll
                for (int hf = 0; hf < 2; ++hf) { const int kk = lane + 64 * hf; const float dv = dots[kk] * uinv;
                    const float z = 1.5957691216057308f * (dv + 0.044715f * dv * dv * dv);
                    gt[kk] = gt[kk] * dv * sigmoidf_(z); }
                LDS_WAIT();
#if PEER_F16
                h16x2 oh[16];
#pragma unroll
                for (int m = 0; m < 16; ++m) oh[m] = (h16x2){(_Float16)0.f, (_Float16)0.f};
#else
                float oa[32];
#pragma unroll
                for (int m = 0; m < 32; ++m) oa[m] = 0.f;
#endif
#if PEER_DEPTH3
                V_ISSUE(va, vtab, 0); V_ISSUE(vbb, vtab, 4);
#pragma unroll 1
                for (int k0 = 0; k0 < 120; k0 += 12) {
                    V_ISSUE(vc, vtab, k0 + 8);
                    PEER_AXPY(va, k0);
                    V_ISSUE(va, vtab, k0 + 12);
                    PEER_AXPY(vbb, k0 + 4);
                    V_ISSUE(vbb, vtab, k0 + 16);
                    PEER_AXPY(vc, k0 + 8);
                }
                PEER_AXPY(va, 120); PEER_AXPY(vbb, 124);
#else
                V_ISSUE(va, vtab, 0);
#pragma unroll 1
                for (int k0 = 0; k0 < 128; k0 += 8) {
                    V_ISSUE(vbb, vtab, k0 + 4);
                    PEER_AXPY(va, k0);
                    if (k0 + 8 < 128) V_ISSUE(va, vtab, k0 + 8);
                    PEER_AXPY(vbb, k0 + 4);
                }
#endif
#if PEER_F16
                float oa[32];
#pragma unroll
                for (int m = 0; m < 16; ++m) { oa[2 * m] = (float)oh[m][0]; oa[2 * m + 1] = (float)oh[m][1]; }
#endif
                float* orow = a.out + (size_t)t * 2048 + 32 * lane;
                float ss = 0.f;
#pragma unroll
                for (int q4 = 0; q4 < 8; ++q4) {
                    const f32x4 x1 = *(const f32x4*)(orow + 4 * q4);
                    const f32x4 g2 = *(const LAS f32x4*)(g2l + (q4 * 64 + lane) * 4);
#pragma unroll
                    for (int e = 0; e < 4; ++e) { const float v2 = x1[e] + g2[e] * oa[4 * q4 + e] * vinv; oa[4 * q4 + e] = v2; ss += v2 * v2; }
                }
                const float rstd = 1.0f / sqrtf(wave_sum(ss) * (1.0f / D) + EPS);
#pragma unroll
                for (int q4 = 0; q4 < 8; ++q4) {
                    const f32x4 fg = *(const f32x4*)(a.final_norm_gain + 32 * lane + 4 * q4);
                    f32x4 o; o.x = oa[4 * q4] * rstd * fg.x; o.y = oa[4 * q4 + 1] * rstd * fg.y; o.z = oa[4 * q4 + 2] * rstd * fg.z; o.w = oa[4 * q4 + 3] * rstd * fg.w;
                    *(f32x4*)(orow + 4 * q4) = o;
                }
                LDS_WAIT();
            }
        }
#undef INS16
#undef PEER_DOT
#undef PEER_AXPY
    }
#undef IN
#undef SEAM
}

static_assert(12288 * 8 <= CTL_SCALE && CTL_BAR + XCD_BAR_WORDS * 4 <= CTL_ZERO_BYTES, "control block layout");
extern "C" void kernel_launch(void* const* d_in, const int* in_sizes, int n_in, void* d_out, int out_size, void* d_ws, size_t ws_size, hipStream_t stream) {
    static int grid = 0;
    if (grid == 0) {
        if (n_in != 19 || out_size != S * D || ws_size < WS_END) { fprintf(stderr, "kernel_launch: unexpected problem (n_in %d out %d ws %zu)\n", n_in, out_size, ws_size); grid = -1; return; }
        int dev = 0, cus = 0, per_cu = 0;
        hipGetDevice(&dev); hipDeviceGetAttribute(&cus, hipDeviceAttributeMultiprocessorCount, dev);
        hipFuncSetAttribute((const void*)mk_fwd, hipFuncAttributeMaxDynamicSharedMemorySize, LDS_BYTES);
        hipOccupancyMaxActiveBlocksPerMultiprocessor(&per_cu, (const void*)mk_fwd, 512, LDS_BYTES);
        (void)hipGetLastError();
        if (per_cu < 1) { fprintf(stderr, "kernel_launch: occupancy query says %d blocks per CU\n", per_cu); per_cu = 1; }
        grid = cus * 1;
    }
    if (grid < 0) return;
    hipMemsetAsync((char*)d_ws + WS_CTL, 0, CTL_ZERO_BYTES, stream);
    Args a{};
    a.x = (const float*)d_in[0]; a.c = (const float*)d_in[1]; a.positions = (const int*)d_in[2]; a.norm_mix_gain = (const float*)d_in[3];
    a.w_ada = (const float*)d_in[4]; a.b_ada = (const float*)d_in[5]; a.w_in = (const float*)d_in[6]; a.pool_w = (const float*)d_in[7];
    a.pool_scale = (const float*)d_in[8]; a.ret_norm_gain = (const float*)d_in[9]; a.w_branch_pool = (const float*)d_in[10]; a.w_branch_ret = (const float*)d_in[11];
    a.w_out = (const float*)d_in[12]; a.norm_ffn_gain = (const float*)d_in[13]; a.peer_w_query = (const float*)d_in[14]; a.peer_sub_keys = (const float*)d_in[15];
    a.peer_u = (const float*)d_in[16]; a.peer_v = (const float*)d_in[17]; a.final_norm_gain = (const float*)d_in[18];
    a.out = (float*)d_out; a.ws = (unsigned char*)d_ws;
#if MK_N_LAUNCHES == 1
    a.ph_lo = 0; a.ph_hi = NPHASE;
    void* args[] = {&a};
    hipError_t e = hipLaunchCooperativeKernel((const void*)mk_fwd, dim3(grid), dim3(512), args, LDS_BYTES, stream);
    if (e != hipSuccess) fprintf(stderr, "cooperative launch failed: %s (grid %d)\n", hipGetErrorString(e), grid);
#else
    for (int p = 0; p < NPHASE; ++p) { a.ph_lo = p; a.ph_hi = p + 1; hipLaunchKernelGGL(mk_fwd, dim3(grid), dim3(512), LDS_BYTES, stream, a); }
#endif
}
```

```cpp
#include <hip/hip_runtime.h>
#include <hip/hip_cooperative_groups.h>
#include <cstdio>
#include <cstdint>
namespace cg = cooperative_groups;

#ifndef PEER_UMFMA
#define PEER_UMFMA 1
#endif
#ifndef PEER_VSPLIT
#define PEER_VSPLIT 1
#endif
#ifndef PEER_VMFMA
#define PEER_VMFMA 1
#endif
#ifndef PEER_UFP4
#define PEER_UFP4 1
#endif
#ifndef PEER_VFP4
#define PEER_VFP4 1
#endif
#ifndef PEER_DEPTH3
#define PEER_DEPTH3 0
#endif
#ifndef PEER_F16
#define PEER_F16 1
#endif
#ifndef MK_N_LAUNCHES
#define MK_N_LAUNCHES 1
#endif

#define LAS __attribute__((address_space(3)))
typedef unsigned short bf16_t;
typedef short bf16x8 __attribute__((ext_vector_type(8)));
typedef float f32x4 __attribute__((ext_vector_type(4)));
typedef float f32x2 __attribute__((ext_vector_type(2)));
typedef unsigned u32x4 __attribute__((ext_vector_type(4)));
typedef unsigned u32x2 __attribute__((ext_vector_type(2)));
typedef unsigned u32x6 __attribute__((ext_vector_type(6)));
typedef float f32x32 __attribute__((ext_vector_type(32)));
typedef _Float16 h16x2 __attribute__((ext_vector_type(2)));
typedef _Float16 h16x32 __attribute__((ext_vector_type(32)));

constexpr int NB16 = 2048;
constexpr int S = 16384, D = 2048, NIN = 18432, RH = 8, DK = 256, DV = 512, VW = 4096, NE = 16384;
constexpr float EPS = 1e-6f;
constexpr int NPHASE = 12;

constexpr size_t MiB = 1u << 20;
constexpr size_t WS_CTL = 0;
constexpr size_t CTL_SCALE = 100 * 1024, CTL_BAR = 104 * 1024, CTL_ZERO_BYTES = 128 * 1024;
constexpr size_t WS_WOUT = 1 * MiB;
constexpr size_t WS_WQS = 9 * MiB;
constexpr size_t WS_WIN = 17 * MiB;
constexpr size_t WS_POOLED = WS_WIN;
constexpr size_t WS_UPOOL = 89 * MiB;
constexpr size_t WS_MERGED = WS_UPOOL;
constexpr size_t WS_Q = 153 * MiB;
constexpr size_t WS_K = 217 * MiB;
#define TAB_IN_RET (PEER_UFP4 && PEER_VFP4)
#if TAB_IN_RET
constexpr size_t WS_UTAB = 665 * MiB;
constexpr size_t WS_VTAB = 681 * MiB;
#else
constexpr size_t WS_UTAB = WS_Q;
constexpr size_t WS_VTAB = WS_Q + 32 * MiB;
#endif
constexpr size_t WS_V = 281 * MiB;
constexpr size_t WS_SCORES = WS_V;
constexpr size_t WS_GRET = 409 * MiB;
constexpr size_t WS_FN = WS_GRET;
constexpr size_t WS_HN8 = 473 * MiB;
constexpr size_t WS_SAP = 537 * MiB;
constexpr size_t WS_SAR = 601 * MiB;
constexpr size_t WS_END = (TAB_IN_RET ? 697 : 665) * MiB;
constexpr size_t DO_HN = 0;
constexpr size_t DO_RCOS = 64 * MiB;
constexpr size_t DO_RSIN = 72 * MiB;
constexpr size_t DO_WPC = 80 * MiB;
constexpr size_t DO_PRET = 88 * MiB;

constexpr int LDS_BYTES = 147456;

__device__ __forceinline__ unsigned f2bf(float f) { unsigned u = __builtin_bit_cast(unsigned, f); return (u + 0x7fffu + ((u >> 16) & 1u)) >> 16; }
typedef __bf16 bf16n2 __attribute__((ext_vector_type(2)));
__device__ __forceinline__ unsigned pk2(float lo, float hi) { const f32x2 v = {lo, hi}; return __builtin_bit_cast(unsigned, __builtin_convertvector(v, bf16n2)); }
__device__ __forceinline__ float bf_lo(unsigned u) { return __builtin_bit_cast(float, u << 16); }
__device__ __forceinline__ float bf_hi(unsigned u) { return __builtin_bit_cast(float, u & 0xffff0000u); }
__device__ __forceinline__ float wave_sum(float v) {
#define WS_DPP(C) v += __builtin_bit_cast(float, __builtin_amdgcn_update_dpp(0, __builtin_bit_cast(int, v), C, 0xF, 0xF, true))
    WS_DPP(0xB1); WS_DPP(0x4E); WS_DPP(0x141); WS_DPP(0x140);
#undef WS_DPP
    const int b_ = __builtin_bit_cast(int, v);
    return (__builtin_bit_cast(float, __builtin_amdgcn_readlane(b_, 0)) + __builtin_bit_cast(float, __builtin_amdgcn_readlane(b_, 16)))
         + (__builtin_bit_cast(float, __builtin_amdgcn_readlane(b_, 32)) + __builtin_bit_cast(float, __builtin_amdgcn_readlane(b_, 48)));
}
#define LDS_WAIT() asm volatile("s_waitcnt lgkmcnt(0)" ::: "memory")
constexpr double MOD_FX = 1099511627776.0;
__device__ __forceinline__ int lane_id() { int r; asm volatile("v_mbcnt_lo_u32_b32 %0, -1, 0\n\tv_mbcnt_hi_u32_b32 %0, -1, %0" : "=v"(r)); return r; }
__device__ __forceinline__ int launder(int x) { asm volatile("" : "+v"(x)); return x; }
__device__ __forceinline__ float modval(const long long* macc, const float* b_ada, int i) { return (float)((double)macc[i] * (1.0 / MOD_FX)) + b_ada[i]; }

namespace pg8 {
constexpr int BM = 256, BK = 64, HALF = 128, HTB = HALF * BK * 2, STAGE_BYTES = 8 * HTB, NXCD = 8, WGM = 8;
__host__ __device__ __forceinline__ int lds_byte(int r, int c) { const int st = (r >> 4) * 2 + (c >> 5), rr = r & 15, cc = c & 31, ob = rr * 64 + cc * 2; return st * 1024 + (ob ^ (((ob >> 9) & 1) << 5)); }
__host__ __device__ __forceinline__ void stage_rc(int b, int& R, int& C) { const int st = b / 1024, sb = b % 1024, swz = sb ^ (((sb >> 9) & 1) << 5); R = (st >> 1) * 16 + swz / 64; C = (st & 1) * 32 + (swz % 64) / 2; }
__host__ __device__ __forceinline__ int perm32(int rho) { const int n = rho >> 4, i = rho & 15; return 8 * (i >> 2) + 4 * n + (i & 3); }
struct Unit { int pm, pn; };
struct Gemm { const bf16_t* A; const bf16_t* Bt; int M, N, K; };
struct StaticOrder {
    int nM, nN, nwg, G, c;
    __host__ __device__ void init(int M, int N, int G_, int c_) { nM = M / BM; nN = N / BM; nwg = nM * nN; G = G_; c = c_; }
    __host__ __device__ bool next(int i, Unit& u) const {
        const long L = (long)i * G + c; if (L >= nwg) return false;
        int wgid = (int)L; { const int q = nwg / NXCD, r = nwg % NXCD, xcd = wgid % NXCD, off = wgid / NXCD; wgid = (xcd < r ? xcd * (q + 1) : r * (q + 1) + (xcd - r) * q) + off; }
        const int nig = WGM * nN, gid = wgid / nig, fm = gid * WGM, gsz = (nM - fm) < WGM ? (nM - fm) : WGM;
        u.pm = fm + ((wgid % nig) % gsz); u.pn = (wgid % nig) / gsz; return true;
    }
};
typedef int i32x4_t __attribute__((ext_vector_type(4)));
typedef int i32x8_t __attribute__((ext_vector_type(8)));
typedef int i32x2_t __attribute__((ext_vector_type(2)));
__device__ __forceinline__ i32x8_t cat8(const bf16x8& lo, const bf16x8& hi) { return __builtin_shufflevector(__builtin_bit_cast(i32x4_t, lo), __builtin_bit_cast(i32x4_t, hi), 0, 1, 2, 3, 4, 5, 6, 7); }
__device__ __forceinline__ void mfma_fp8(f32x4& c, const i32x8_t& a, const i32x8_t& b, int sa, int sb) {
    asm volatile("v_mfma_scale_f32_16x16x128_f8f6f4 %0, %1, %2, %0, %3, %4 op_sel_hi:[0,0,0]" : "+v"(c) : "v"(a), "v"(b), "v"(sa), "v"(sb));
}
template <class Epi, bool ALIGN_EPI = true, bool SP2 = true, bool FP8 = false>
__device__ __forceinline__ void gemm_phase(LAS unsigned char* lds, const Gemm g, const StaticOrder& S, const Epi& E, int wid) {
    const int lane = launder(lane_id()), tid = wid * 64 + lane, wr = wid >> 2, wc = wid & 3, fr = lane & 15, fq = lane >> 4;
    constexpr int EB = FP8 ? 1 : 2;
    const int K = g.K, nt = K * EB / (BK * 2);
    unsigned voffA[2], voffB[2];
#pragma unroll
    for (int i = 0; i < 2; ++i) { int R, C; stage_rc(tid * 16 + i * 8192, R, C); const int Rb = Epi::PERM ? ((R & ~31) + perm32(R & 31)) : R;
        voffA[i] = (unsigned)(R * K * EB + C * 2); voffB[i] = (unsigned)(Rb * K * EB + C * 2); }
    const size_t kstep = (size_t)(BK * 2);
    const size_t hstep = (size_t)HALF * K * EB;
    const size_t tstep = 2 * hstep;
    const unsigned ldsw = (unsigned)wid * 1024u;
    const int aoff = lds_byte(wr * 64 + fr, fq * 8), boff = lds_byte(wc * 32 + fr, fq * 8);
#define PG8_SA(b, h) (((b) * 2 + (h)) * HTB)
#define PG8_SB(b, h) ((4 + (b) * 2 + (h)) * HTB)
#define PG8_STAGE(bufoff, gbase, voff) do { _Pragma("unroll") for (int _i = 0; _i < 2; ++_i) \
        __builtin_amdgcn_global_load_lds((const unsigned*)((const char*)(gbase) + (voff)[_i]), (LAS unsigned*)(lds + (bufoff) + ldsw + _i * 8192), 16, 0, 0); } while (0)
#define PG8_LDA(dst, b, h) do { _Pragma("unroll") for (int m = 0; m < 4; ++m) _Pragma("unroll") for (int k = 0; k < 2; ++k) dst[m][k] = *(const LAS bf16x8*)(lds + PG8_SA(b, h) + aoff + m * 2048 + k * 1024); } while (0)
#define PG8_LDB(dst, b, h) do { _Pragma("unroll") for (int n = 0; n < 2; ++n) _Pragma("unroll") for (int k = 0; k < 2; ++k) dst[n][k] = *(const LAS bf16x8*)(lds + PG8_SB(b, h) + boff + n * 2048 + k * 1024); } while (0)
#define PG8_MMA(ai, bj, At, Bt) do { __builtin_amdgcn_s_setprio(1); if constexpr (FP8) asm volatile("s_nop 3"); _Pragma("unroll") for (int m = 0; m < 4; ++m) _Pragma("unroll") for (int n = 0; n < 2; ++n) { \
        if constexpr (FP8) mfma_fp8(acc[ai][bj][m][n], cat8(Bt[n][0], Bt[n][1]), cat8(At[m][0], At[m][1]), sc_w, sc_a); \
        else { _Pragma("unroll") for (int k = 0; k < 2; ++k) acc[ai][bj][m][n] = __builtin_amdgcn_mfma_f32_16x16x32_bf16(Bt[n][k], At[m][k], acc[ai][bj][m][n], 0, 0, 0); } } __builtin_amdgcn_s_setprio(0); } while (0)
#define PG8_WAIT_V(n) asm volatile("s_waitcnt vmcnt(" #n ")" ::: "memory")
#define PG8_WAIT_L(n) asm volatile("s_waitcnt lgkmcnt(" #n ")" ::: "memory")
#define PG8_BAR __builtin_amdgcn_s_barrier()
#define PG8_SCHED __builtin_amdgcn_sched_barrier(0)
    Unit cur, nxt; int ui = 0;
    if (!S.next(0, cur)) return;
    const int sc_w = 0x76767676, sc_a = 0x7C7C7C7C;
    f32x4 acc[2][2][4][2];
#pragma unroll
    for (int a = 0; a < 2; ++a)
#pragma unroll
        for (int b = 0; b < 2; ++b)
#pragma unroll
            for (int m = 0; m < 4; ++m)
#pragma unroll
                for (int n = 0; n < 2; ++n) acc[a][b][m][n] = (f32x4){0.f, 0.f, 0.f, 0.f};
    bf16x8 At[4][2], B0[2][2], B1[2][2];
    const char* cA = (const char*)g.A + (size_t)cur.pm * tstep; const char* cB = (const char*)g.Bt + (size_t)cur.pn * tstep;
    if constexpr (SP2) {
        PG8_STAGE(PG8_SB(0, 0), cB, voffB); PG8_STAGE(PG8_SB(0, 1), cB + hstep, voffB); PG8_STAGE(PG8_SA(0, 0), cA, voffA); PG8_STAGE(PG8_SA(0, 1), cA + hstep, voffA);
        if (wr == 1) PG8_BAR;
        PG8_WAIT_V(2); PG8_BAR;
        PG8_STAGE(PG8_SB(1, 0), cB + kstep, voffB); PG8_STAGE(PG8_SA(1, 0), cA + kstep, voffA); PG8_STAGE(PG8_SB(1, 1), cB + hstep + kstep, voffB);
        PG8_WAIT_V(6); PG8_BAR;
    } else {
        PG8_STAGE(PG8_SB(0, 0), cB, voffB); PG8_STAGE(PG8_SA(0, 0), cA, voffA); PG8_STAGE(PG8_SB(0, 1), cB + hstep, voffB); PG8_STAGE(PG8_SA(0, 1), cA + hstep, voffA);
        if (wr == 1) PG8_BAR;
        PG8_WAIT_V(4); PG8_BAR;
        PG8_STAGE(PG8_SB(1, 0), cB + kstep, voffB); PG8_STAGE(PG8_SA(1, 0), cA + kstep, voffA); PG8_STAGE(PG8_SB(1, 1), cB + hstep + kstep, voffB);
        PG8_WAIT_V(6); PG8_BAR;
    }
    for (;;) {
        const bool has_next = S.next(ui + 1, nxt);
        const char* nA = has_next ? (const char*)g.A + (size_t)nxt.pm * tstep : cA; const char* nB = has_next ? (const char*)g.Bt + (size_t)nxt.pn * tstep : cB;
        for (int t = 0; t < nt; t += 2) {
            const bool last = (t == nt - 2);
            const char* a1 = cA + (size_t)(t + 1) * kstep;
            const char* a2 = last ? nA : cA + (size_t)(t + 2) * kstep; const char* b2 = last ? nB : cB + (size_t)(t + 2) * kstep;
            const char* a3 = a2 + kstep; const char* b3 = b2 + kstep;
            if constexpr (SP2) {
            PG8_LDB(B0, 0, 0); PG8_LDB(B1, 0, 1); PG8_SCHED; PG8_LDA(At, 0, 0); PG8_STAGE(PG8_SA(1, 1), a1 + hstep, voffA);
            PG8_WAIT_V(8); PG8_WAIT_L(0); PG8_BAR; PG8_MMA(0, 0, At, B0); PG8_MMA(0, 1, At, B1); PG8_BAR; PG8_SCHED;
            PG8_LDA(At, 0, 1); PG8_STAGE(PG8_SB(0, 0), b2, voffB); PG8_STAGE(PG8_SB(0, 1), b2 + hstep, voffB); PG8_STAGE(PG8_SA(0, 0), a2, voffA);
            PG8_WAIT_V(8); PG8_WAIT_L(0); PG8_BAR; PG8_MMA(1, 0, At, B0); PG8_MMA(1, 1, At, B1); PG8_BAR; PG8_SCHED;
            PG8_LDB(B0, 1, 0); PG8_LDB(B1, 1, 1); PG8_SCHED; PG8_LDA(At, 1, 0); PG8_STAGE(PG8_SA(0, 1), a2 + hstep, voffA);
            PG8_WAIT_V(8); PG8_WAIT_L(0); PG8_BAR; PG8_MMA(0, 0, At, B0); PG8_MMA(0, 1, At, B1); PG8_BAR; PG8_SCHED;
            PG8_LDA(At, 1, 1); PG8_STAGE(PG8_SB(1, 0), b3, voffB); PG8_STAGE(PG8_SB(1, 1), b3 + hstep, voffB); PG8_STAGE(PG8_SA(1, 0), a3, voffA);
            PG8_WAIT_V(8); PG8_WAIT_L(0); PG8_BAR; PG8_MMA(1, 0, At, B0); PG8_MMA(1, 1, At, B1); PG8_BAR; PG8_SCHED;
            } else {
            PG8_LDB(B0, 0, 0); PG8_SCHED; PG8_LDA(At, 0, 0); PG8_STAGE(PG8_SA(1, 1), a1 + hstep, voffA);
            PG8_WAIT_L(8); PG8_BAR; PG8_WAIT_L(0); PG8_MMA(0, 0, At, B0); PG8_BAR; PG8_SCHED;
            PG8_LDB(B1, 0, 1); PG8_STAGE(PG8_SB(0, 0), b2, voffB);
            PG8_BAR; PG8_WAIT_L(0); PG8_MMA(0, 1, At, B1); PG8_BAR;
            PG8_LDA(At, 0, 1); PG8_STAGE(PG8_SA(0, 0), a2, voffA);
            PG8_BAR; PG8_WAIT_L(0); PG8_MMA(1, 0, At, B0); PG8_BAR; PG8_SCHED;
            PG8_STAGE(PG8_SB(0, 1), b2 + hstep, voffB);
            PG8_WAIT_V(6); PG8_BAR; PG8_MMA(1, 1, At, B1); PG8_BAR;
            PG8_LDB(B0, 1, 0); PG8_SCHED; PG8_LDA(At, 1, 0); PG8_STAGE(PG8_SA(0, 1), a2 + hstep, voffA);
            PG8_WAIT_L(8); PG8_BAR; PG8_WAIT_L(0); PG8_MMA(0, 0, At, B0); PG8_BAR; PG8_SCHED;
            PG8_LDB(B1, 1, 1); PG8_STAGE(PG8_SB(1, 0), b3, voffB);
            PG8_BAR; PG8_WAIT_L(0); PG8_MMA(0, 1, At, B1); PG8_BAR;
            PG8_LDA(At, 1, 1); PG8_STAGE(PG8_SA(1, 0), a3, voffA);
            PG8_BAR; PG8_WAIT_L(0); PG8_MMA(1, 0, At, B0); PG8_BAR; PG8_SCHED;
            PG8_STAGE(PG8_SB(1, 1), b3 + hstep, voffB);
            PG8_WAIT_V(6); PG8_BAR; PG8_MMA(1, 1, At, B1); PG8_BAR;
            }
        }
        if constexpr (ALIGN_EPI) { if (wr == 0) PG8_BAR; }
        if constexpr (FP8) asm volatile("s_nop 15\n\ts_nop 7" ::: "memory");
        if constexpr (FP8) { const int l2 = launder(lane_id()); E(acc, cur, wr, wc, l2 & 15, l2 >> 4); }
        else E(acc, cur, wr, wc, fr, fq);
        if (!has_next) break;
#pragma unroll
        for (int a = 0; a < 2; ++a)
#pragma unroll
            for (int b = 0; b < 2; ++b)
#pragma unroll
                for (int m = 0; m < 4; ++m)
#pragma unroll
                    for (int n = 0; n < 2; ++n) acc[a][b][m][n] = (f32x4){0.f, 0.f, 0.f, 0.f};
        cur = nxt; cA = nA; cB = nB; ++ui;
        if constexpr (ALIGN_EPI) { if (wr == 1) PG8_BAR; }
    }
    PG8_WAIT_V(0);
    if constexpr (!ALIGN_EPI) { if (wr == 0) PG8_BAR; }
    PG8_BAR;
#undef PG8_SA
#undef PG8_SB
#undef PG8_STAGE
#undef PG8_LDA
#undef PG8_LDB
#undef PG8_MMA
#undef PG8_WAIT_V
#undef PG8_WAIT_L
#undef PG8_BAR
#undef PG8_SCHED
}
}

#define XB_TMO      128
#define XB_XCNT(j)  (256  + 64 * (j))
#define XB_XSUB(j)  (1280 + 64 * (j))
#define XB_XGEN(j)  (2304 + 64 * (j))
#define XB_TOP      3328
#define XB_TOPGEN   3392
#define XCD_BAR_WORDS 3456
#define XB_SPIN_CAP (1u << 18)
__device__ __forceinline__ unsigned xb_ld(unsigned* p)              { return __hip_atomic_load(p, __ATOMIC_RELAXED, __HIP_MEMORY_SCOPE_AGENT); }
__device__ __forceinline__ unsigned xb_add(unsigned* p, unsigned v) { return __hip_atomic_fetch_add(p, v, __ATOMIC_RELAXED, __HIP_MEMORY_SCOPE_AGENT); }
__device__ __forceinline__ unsigned xb_xcc_id() { return (unsigned)__builtin_amdgcn_s_getreg((3 << 11) | 20) & 0xFu; }
#define XB_SPIN(cond, bar) do { unsigned _sp = 0; while (cond) { __builtin_amdgcn_s_sleep(1); \
    if ((++_sp & 255u) == 0u) { if (xb_ld(&(bar)[XB_TMO])) break; if (_sp > XB_SPIN_CAP) { atomicAdd(&(bar)[XB_TMO], 1u); break; } } } } while (0)
struct XcdBarrier { unsigned* bar; unsigned x; volatile LAS unsigned* st; int wave; };
__device__ __forceinline__ XcdBarrier xcd_barrier_post(unsigned* bar, volatile LAS unsigned* st, int wave) {
    XcdBarrier b; b.bar = bar; b.x = xb_xcc_id(); b.st = st; b.wave = wave;
    if (wave == 0 && lane_id() == 0) (void)xb_add(&bar[XB_XCNT(b.x)], 1u);
    return b;
}
__device__ __forceinline__ void xcd_barrier_complete(unsigned* bar, unsigned x, unsigned& nloc, unsigned& nx) {
    const unsigned G = gridDim.x * gridDim.y * gridDim.z;
    unsigned sum, cnt, mine, sp = 0u;
    for (;;) {
        sum = 0u; cnt = 0u; mine = 0u;
#pragma unroll
        for (unsigned j = 0; j < 16; ++j) { const unsigned c = xb_ld(&bar[XB_XCNT(j)]); sum += c; cnt += (c > 0u) ? 1u : 0u; mine = (j == x) ? c : mine; }
        if (sum == G) break;
        __builtin_amdgcn_s_sleep(1);
        if ((++sp & 255u) == 0u) { if (xb_ld(&bar[XB_TMO])) break; if (sp > XB_SPIN_CAP) { atomicAdd(&bar[XB_TMO], 1u); break; } }
    }
    nloc = mine > 0u ? mine : 1u; nx = cnt > 0u ? cnt : 1u;
}
__device__ __forceinline__ void xcd_barrier(const XcdBarrier& b) {
    asm volatile("s_waitcnt vmcnt(0)" ::: "memory");
    __syncthreads();
    if (b.wave == 0 && lane_id() == 0) {
        unsigned* bar = b.bar;
        __builtin_amdgcn_s_waitcnt(0);
        unsigned nloc = b.st[0], nx = b.st[1];
        if (nloc == 0u) { xcd_barrier_complete(bar, b.x, nloc, nx); b.st[0] = nloc; b.st[1] = nx; }
        const unsigned old = xb_add(&bar[XB_XSUB(b.x)], 1u);
        const unsigned gen = old / nloc;
        if (old + 1u == (gen + 1u) * nloc) {
            __builtin_amdgcn_fence(__ATOMIC_RELEASE, "agent");
            asm volatile("s_waitcnt vmcnt(0)" ::: "memory");
#pragma unroll
            for (unsigned j = 0; j < 16; ++j) (void)__hip_atomic_fetch_add(&bar[XB_XGEN(j)], 1u, __ATOMIC_RELAXED, __HIP_MEMORY_SCOPE_AGENT);
        }
        const unsigned want = (gen + 1u) * nx;
        XB_SPIN(xb_ld(&bar[XB_XGEN(b.x)]) < want, bar);
        __builtin_amdgcn_fence(__ATOMIC_ACQUIRE, "agent");
        asm volatile("s_waitcnt vmcnt(0)" ::: "memory");
    }
    __syncthreads();
}

struct Args {
    const float* x; const float* c; const int* positions; const float* norm_mix_gain; const float* w_ada; const float* b_ada; const float* w_in;
    const float* pool_w; const float* pool_scale; const float* ret_norm_gain; const float* w_branch_pool; const float* w_branch_ret; const float* w_out;
    const float* norm_ffn_gain; const float* peer_w_query; const float* peer_sub_keys; const float* peer_u; const float* peer_v; const float* final_norm_gain;
    float* out; unsigned char* ws; int ph_lo, ph_hi;
};

__device__ __forceinline__ float sigmoidf_(float x) { return __builtin_amdgcn_rcpf(1.0f + __expf(-x)); }

template <int PART  >
struct EpiG1 {
    static constexpr bool PERM = true;
    bf16_t *upool, *q, *k, *v; unsigned char *gret, *sap, *sar; const float *rcos, *rsin; int pn_off;
    __device__ __forceinline__ void operator()(const f32x4 (&acc)[2][2][4][2], const pg8::Unit& u, int wr, int wc, int fr, int fq) const {
        const int pn = u.pn + pn_off, row0 = u.pm * 256 + wr * 64 + fr, cw = wc * 32 + 8 * fq;
        if (pn >= 8 && pn < 24) {
            bf16_t* base = (pn < 16) ? q : k; const int head = (pn - 8) & 7; const float sc = (pn < 16) ? 1.0f : 0.0625f;
#pragma unroll
            for (int ai = 0; ai < 2; ++ai) {
                f32x4 cs[4][4];
#pragma unroll
                for (int m = 0; m < 4; ++m) {
                    const size_t ro = (size_t)(row0 + ai * 128 + m * 16) * 128 + cw;
                    cs[m][0] = *(const f32x4*)(rcos + ro); cs[m][1] = *(const f32x4*)(rcos + ro + 4); cs[m][2] = *(const f32x4*)(rsin + ro); cs[m][3] = *(const f32x4*)(rsin + ro + 4);
                }
                __builtin_amdgcn_sched_barrier(0);
#pragma unroll
                for (int m = 0; m < 4; ++m) {
                    const int row = row0 + ai * 128 + m * 16;
                    const f32x4 c0 = cs[m][0], c1 = cs[m][1], s0 = cs[m][2], s1 = cs[m][3];
                    const f32x4 a0 = acc[ai][0][m][0], a1 = acc[ai][0][m][1], b0 = acc[ai][1][m][0], b1 = acc[ai][1][m][1];
                    const f32x4 p0 = (a0 * c0 - b0 * s0) * sc, p1 = (a1 * c1 - b1 * s1) * sc, r0 = (b0 * c0 + a0 * s0) * sc, r1 = (b1 * c1 + a1 * s1) * sc;
                    bf16_t* rowp = base + (size_t)row * 2048 + head * 256 + cw;
                    u32x4 w; w.x = pk2(p0[0], p0[1]); w.y = pk2(p0[2], p0[3]); w.z = pk2(p1[0], p1[1]); w.w = pk2(p1[2], p1[3]);
                    *(u32x4*)rowp = w;
                    w.x = pk2(r0[0], r0[1]); w.y = pk2(r0[2], r0[3]); w.z = pk2(r1[0], r1[1]); w.w = pk2(r1[2], r1[3]);
                    *(u32x4*)(rowp + 128) = w;
                }
            }
        } else {
            if (PART == 1 && pn >= 56) {
                unsigned char* gb = ((pn < 64) ? sap : sar) + ((pn - 56) & 7) * 256 + cw;
#pragma unroll
                for (int ai = 0; ai < 2; ++ai)
#pragma unroll
                    for (int m = 0; m < 4; ++m) {
                        unsigned char* rowp = gb + (size_t)(row0 + ai * 128 + m * 16) * 2048;
#pragma unroll
                        for (int bj = 0; bj < 2; ++bj) {
                            const f32x4 v0 = acc[ai][bj][m][0], v1 = acc[ai][bj][m][1];
                            unsigned w0 = 0u, w1 = 0u;
                            w0 = __builtin_amdgcn_cvt_pk_u8_f32(sigmoidf_(v0[0]) * 255.0f, 0, w0); w0 = __builtin_amdgcn_cvt_pk_u8_f32(sigmoidf_(v0[1]) * 255.0f, 1, w0);
                            w0 = __builtin_amdgcn_cvt_pk_u8_f32(sigmoidf_(v0[2]) * 255.0f, 2, w0); w0 = __builtin_amdgcn_cvt_pk_u8_f32(sigmoidf_(v0[3]) * 255.0f, 3, w0);
                            w1 = __builtin_amdgcn_cvt_pk_u8_f32(sigmoidf_(v1[0]) * 255.0f, 0, w1); w1 = __builtin_amdgcn_cvt_pk_u8_f32(sigmoidf_(v1[1]) * 255.0f, 1, w1);
                            w1 = __builtin_amdgcn_cvt_pk_u8_f32(sigmoidf_(v1[2]) * 255.0f, 2, w1); w1 = __builtin_amdgcn_cvt_pk_u8_f32(sigmoidf_(v1[3]) * 255.0f, 3, w1);
                            u32x2 w; w.x = w0; w.y = w1; *(u32x2*)(rowp + bj * 128) = w;
                            __builtin_amdgcn_sched_barrier(0);
                        }
                    }
                return;
            }
            if (PART == 1 && pn >= 40) {
                unsigned char* gb = gret + (pn - 40) * 256 + cw;
#pragma unroll
                for (int ai = 0; ai < 2; ++ai)
#pragma unroll
                    for (int m = 0; m < 4; ++m) {
                        unsigned char* rowp = gb + (size_t)(row0 + ai * 128 + m * 16) * 4096;
#pragma unroll
                        for (int bj = 0; bj < 2; ++bj) {
                            f32x4 v0 = acc[ai][bj][m][0], v1 = acc[ai][bj][m][1];
#pragma unroll
                            for (int j = 0; j < 4; ++j) { v0[j] *= sigmoidf_(v0[j]); v1[j] *= sigmoidf_(v1[j]); }
                            int w0 = __builtin_amdgcn_cvt_pk_fp8_f32(v0[0], v0[1], 0, false); w0 = __builtin_amdgcn_cvt_pk_fp8_f32(v0[2], v0[3], w0, true);
                            int w1 = __builtin_amdgcn_cvt_pk_fp8_f32(v1[0], v1[1], 0, false); w1 = __builtin_amdgcn_cvt_pk_fp8_f32(v1[2], v1[3], w1, true);
                            u32x2 w; w.x = (unsigned)w0; w.y = (unsigned)w1; *(u32x2*)(rowp + bj * 128) = w;
                            __builtin_amdgcn_sched_barrier(0);
                        }
                    }
                return;
            }
            bf16_t* base; int ldc, col; constexpr int kind = 0;
            if (pn < 8) { base = upool; ldc = 2048; col = pn * 256; }
            else { base = v; ldc = 4096; col = (pn - 24) * 256; }
#pragma unroll
            for (int ai = 0; ai < 2; ++ai)
#pragma unroll
                for (int m = 0; m < 4; ++m) {
                    bf16_t* rowp = base + (size_t)(row0 + ai * 128 + m * 16) * ldc + col + cw;
#pragma unroll
                    for (int bj = 0; bj < 2; ++bj) {
                        f32x4 v0 = acc[ai][bj][m][0], v1 = acc[ai][bj][m][1];
                        if (kind != 0) {
#pragma unroll
                            for (int j = 0; j < 4; ++j) { const float g0 = sigmoidf_(v0[j]), g1 = sigmoidf_(v1[j]); v0[j] = (kind == 1) ? v0[j] * g0 : g0; v1[j] = (kind == 1) ? v1[j] * g1 : g1; }
                        }
                        u32x4 w; w.x = pk2(v0[0], v0[1]); w.y = pk2(v0[2], v0[3]); w.z = pk2(v1[0], v1[1]); w.w = pk2(v1[2], v1[3]);
                        *(u32x4*)(rowp + bj * 128) = w;
                    }
                }
        }
    }
};

template <int ADD> struct EpiGate {
    static constexpr bool PERM = true;
    const unsigned char* gate; bf16_t* out;
    __device__ __forceinline__ void operator()(const f32x4 (&acc)[2][2][4][2], const pg8::Unit& u, int wr, int wc, int fr, int fq) const {
        const int row0 = u.pm * 256 + wr * 64 + fr, col0 = u.pn * 256 + wc * 32 + 8 * fq;
#pragma unroll
        for (int ai = 0; ai < 2; ++ai) {
            u32x2 gv[4][2]; u32x4 pv[4][2];
#pragma unroll
            for (int m = 0; m < 4; ++m)
#pragma unroll
                for (int bj = 0; bj < 2; ++bj) { const size_t off = (size_t)(row0 + ai * 128 + m * 16) * 2048 + col0 + bj * 128; gv[m][bj] = *(const u32x2*)(gate + off); if (ADD) pv[m][bj] = *(const u32x4*)(out + off); }
            __builtin_amdgcn_sched_barrier(0);
#pragma unroll
            for (int m = 0; m < 4; ++m)
#pragma unroll
                for (int bj = 0; bj < 2; ++bj) {
                    const size_t off = (size_t)(row0 + ai * 128 + m * 16) * 2048 + col0 + bj * 128;
                    const u32x2 g = gv[m][bj]; constexpr float U8 = 1.0f / 255.0f;
                    f32x4 v0 = acc[ai][bj][m][0], v1 = acc[ai][bj][m][1];
                    v0[0] *= (float)(g.x & 0xffu) * U8; v0[1] *= (float)((g.x >> 8) & 0xffu) * U8; v0[2] *= (float)((g.x >> 16) & 0xffu) * U8; v0[3] *= (float)(g.x >> 24) * U8;
                    v1[0] *= (float)(g.y & 0xffu) * U8; v1[1] *= (float)((g.y >> 8) & 0xffu) * U8; v1[2] *= (float)((g.y >> 16) & 0xffu) * U8; v1[3] *= (float)(g.y >> 24) * U8;
                    if (ADD) { const u32x4 pq = pv[m][bj];
                        v0[0] += bf_lo(pq.x); v0[1] += bf_hi(pq.x); v0[2] += bf_lo(pq.y); v0[3] += bf_hi(pq.y);
                        v1[0] += bf_lo(pq.z); v1[1] += bf_hi(pq.z); v1[2] += bf_lo(pq.w); v1[3] += bf_hi(pq.w); }
                    u32x4 w; w.x = pk2(v0[0], v0[1]); w.y = pk2(v0[2], v0[3]); w.z = pk2(v1[0], v1[1]); w.w = pk2(v1[2], v1[3]);
                    *(u32x4*)(out + off) = w;
                }
        }
    }
};

struct EpiRes {
    static constexpr bool PERM = false;
    const float* x; float* out; const long long* modacc; const float* b_ada;
    __device__ __forceinline__ void operator()(const f32x4 (&acc)[2][2][4][2], const pg8::Unit& u, int wr, int wc, int fr, int fq) const {
        const int row0 = u.pm * 256 + wr * 64 + fr, col0 = u.pn * 256 + wc * 32 + 4 * fq;
        f32x4 gv[2][2];
#pragma unroll
        for (int bj = 0; bj < 2; ++bj)
#pragma unroll
            for (int n = 0; n < 2; ++n) { const int c = 2 * D + col0 + bj * 128 + n * 16; gv[bj][n] = (f32x4){modval(modacc, b_ada, c), modval(modacc, b_ada, c + 1), modval(modacc, b_ada, c + 2), modval(modacc, b_ada, c + 3)}; }
#pragma unroll
        for (int ai = 0; ai < 2; ++ai) {
            f32x4 xv[4][2][2];
#pragma unroll
            for (int m = 0; m < 4; ++m)
#pragma unroll
                for (int bj = 0; bj < 2; ++bj)
#pragma unroll
                    for (int n = 0; n < 2; ++n) xv[m][bj][n] = *(const f32x4*)(x + (size_t)(row0 + ai * 128 + m * 16) * 2048 + col0 + bj * 128 + n * 16);
            __builtin_amdgcn_sched_barrier(0);
#pragma unroll
            for (int m = 0; m < 4; ++m)
#pragma unroll
                for (int bj = 0; bj < 2; ++bj)
#pragma unroll
                    for (int n = 0; n < 2; ++n) *(f32x4*)(out + (size_t)(row0 + ai * 128 + m * 16) * 2048 + col0 + bj * 128 + n * 16) = xv[m][bj][n] + gv[bj][n] * acc[ai][bj][m][n];
        }
    }
};

struct EpiBf16Plain {
    static constexpr bool PERM = true;
    bf16_t* out;
    __device__ __forceinline__ void operator()(const f32x4 (&acc)[2][2][4][2], const pg8::Unit& u, int wr, int wc, int fr, int fq) const {
        const int row0 = u.pm * 256 + wr * 64 + fr, col0 = u.pn * 256 + wc * 32 + 8 * fq;
#pragma unroll
        for (int ai = 0; ai < 2; ++ai)
#pragma unroll
            for (int m = 0; m < 4; ++m) {
                bf16_t* rowp = out + (size_t)(row0 + ai * 128 + m * 16) * 2048 + col0;
#pragma unroll
                for (int bj = 0; bj < 2; ++bj) { const f32x4 v0 = acc[ai][bj][m][0], v1 = acc[ai][bj][m][1];
                    u32x4 w; w.x = pk2(v0[0], v0[1]); w.y = pk2(v0[2], v0[3]); w.z = pk2(v1[0], v1[1]); w.w = pk2(v1[2], v1[3]);
                    *(u32x4*)(rowp + bj * 128) = w; }
            }
    }
};

struct EpiF32 {
    static constexpr bool PERM = false;
    float* out;
    __device__ __forceinline__ void operator()(const f32x4 (&acc)[2][2][4][2], const pg8::Unit& u, int wr, int wc, int fr, int fq) const {
        const int row0 = u.pm * 256 + wr * 64 + fr, col0 = u.pn * 256 + wc * 32 + 4 * fq;
#pragma unroll
        for (int ai = 0; ai < 2; ++ai)
#pragma unroll
            for (int m = 0; m < 4; ++m) {
                float* rowp = out + (size_t)(row0 + ai * 128 + m * 16) * 2048 + col0;
#pragma unroll
                for (int bj = 0; bj < 2; ++bj)
#pragma unroll
                    for (int n = 0; n < 2; ++n) *(f32x4*)(rowp + bj * 128 + n * 16) = acc[ai][bj][m][n];
            }
    }
};

__device__ __forceinline__ void transpose_item(const float* W, int K, int N, bf16_t* WT, LAS float* scr, int item, int lane, int n8 = 1 << 30, unsigned char* WT8 = nullptr) {
    const int nblk = N / 32, kb = item / nblk, nb = item % nblk, k0 = 64 * kb, n0 = 32 * nb;
    float tv[32];
#pragma unroll
    for (int i = 0; i < 32; ++i) tv[i] = __builtin_nontemporal_load(&W[(size_t)(k0 + 2 * i + (lane >> 5)) * N + n0 + (lane & 31)]);
#pragma unroll
    for (int i = 0; i < 32; ++i) scr[(2 * i + (lane >> 5)) * 33 + (lane & 31)] = tv[i];
    LDS_WAIT();
    const int c = lane & 7;
    if (n0 >= n8) {
#pragma unroll
        for (int j = 0; j < 4; ++j) { const int n = (lane >> 3) + 8 * j; const LAS float* s = scr + (8 * c) * 33 + n;
            int w0 = __builtin_amdgcn_cvt_pk_fp8_f32(s[0 * 33] * 512.0f, s[1 * 33] * 512.0f, 0, false); w0 = __builtin_amdgcn_cvt_pk_fp8_f32(s[2 * 33] * 512.0f, s[3 * 33] * 512.0f, w0, true);
            int w1 = __builtin_amdgcn_cvt_pk_fp8_f32(s[4 * 33] * 512.0f, s[5 * 33] * 512.0f, 0, false); w1 = __builtin_amdgcn_cvt_pk_fp8_f32(s[6 * 33] * 512.0f, s[7 * 33] * 512.0f, w1, true);
            u32x2 o; o.x = (unsigned)w0; o.y = (unsigned)w1; *(u32x2*)(WT8 + (size_t)(n0 + n - n8) * K + k0 + 8 * c) = o; }
        LDS_WAIT();
        return;
    }
#pragma unroll
    for (int j = 0; j < 4; ++j) { const int n = (lane >> 3) + 8 * j; const LAS float* s = scr + (8 * c) * 33 + n;
        u32x4 o; o.x = pk2(s[0 * 33], s[1 * 33]); o.y = pk2(s[2 * 33], s[3 * 33]); o.z = pk2(s[4 * 33], s[5 * 33]); o.w = pk2(s[6 * 33], s[7 * 33]);
        *(u32x4*)(WT + (size_t)(n0 + n) * K + k0 + 8 * c) = o; }
    LDS_WAIT();
}

template <bool W8 = false>
__device__ __forceinline__ void norm_mod_row2(const float* xrow0, const float* xrow1, const float* gain, const LAS float* shl, const LAS float* scl, bf16_t* orow0, bf16_t* orow1, int lane, unsigned char* o8row0 = nullptr, unsigned char* o8row1 = nullptr) {
    const f32x4* xr0 = (const f32x4*)xrow0 + lane; const f32x4* xr1 = (const f32x4*)xrow1 + lane;
    f32x4 v0[8], v1[8]; float s0 = 0.f, s1 = 0.f;
#pragma unroll
    for (int j = 0; j < 8; ++j) { v0[j] = W8 ? __builtin_nontemporal_load(&xr0[64 * j]) : xr0[64 * j]; v1[j] = W8 ? __builtin_nontemporal_load(&xr1[64 * j]) : xr1[64 * j]; }
#pragma unroll
    for (int j = 0; j < 8; ++j) { s0 += (v0[j].x * v0[j].x + v0[j].y * v0[j].y) + (v0[j].z * v0[j].z + v0[j].w * v0[j].w); s1 += (v1[j].x * v1[j].x + v1[j].y * v1[j].y) + (v1[j].z * v1[j].z + v1[j].w * v1[j].w); }
    const float rstd0 = 1.0f / sqrtf(wave_sum(s0) * (1.0f / D) + EPS), rstd1 = 1.0f / sqrtf(wave_sum(s1) * (1.0f / D) + EPS);
    u32x2* o80 = (u32x2*)orow0 + lane; u32x2* o81 = (u32x2*)orow1 + lane;
#pragma unroll
    for (int j = 0; j < 8; ++j) {
        const int c = 256 * j + 4 * lane;
        const f32x4 g = *(const f32x4*)(gain + c);
        const f32x4 sc = *(const LAS f32x4*)(scl + c) + 1.0f;
        const f32x4 sh = *(const LAS f32x4*)(shl + c);
        const f32x4 y0 = (v0[j] * rstd0 * g) * sc + sh, y1 = (v1[j] * rstd1 * g) * sc + sh;
        u32x2 w; w.x = pk2(y0.x, y0.y); w.y = pk2(y0.z, y0.w); o80[64 * j] = w;
        w.x = pk2(y1.x, y1.y); w.y = pk2(y1.z, y1.w); o81[64 * j] = w;
        if (W8) {
            int q0 = __builtin_amdgcn_cvt_pk_fp8_f32(y0.x * 8.0f, y0.y * 8.0f, 0, false); q0 = __builtin_amdgcn_cvt_pk_fp8_f32(y0.z * 8.0f, y0.w * 8.0f, q0, true);
            int q1 = __builtin_amdgcn_cvt_pk_fp8_f32(y1.x * 8.0f, y1.y * 8.0f, 0, false); q1 = __builtin_amdgcn_cvt_pk_fp8_f32(y1.z * 8.0f, y1.w * 8.0f, q1, true);
            ((unsigned*)o8row0)[64 * j + lane] = (unsigned)q0; ((unsigned*)o8row1)[64 * j + lane] = (unsigned)q1;
        }
    }
}

__device__ __forceinline__ unsigned fkey(float f) { const unsigned u = __builtin_bit_cast(unsigned, f); return (u & 0x80000000u) ? ~u : (u | 0x80000000u); }
__device__ __forceinline__ float fkey_inv(unsigned k) { const unsigned u = (k & 0x80000000u) ? (k & 0x7fffffffu) : ~k; return __builtin_bit_cast(float, u); }
__device__ __forceinline__ unsigned long long wave_max_u64(unsigned long long v) {
#pragma unroll
    for (int o = 1; o < 64; o <<= 1) { const unsigned long long t = __shfl_xor(v, o); v = t > v ? t : v; }
    return v;
}
__device__ __forceinline__ int okey(float f) { const int b = __builtin_bit_cast(int, f); return b ^ ((b >> 31) & 0x7fffffff); }
__device__ __forceinline__ float okey_inv(int k) { const int b = k ^ ((k >> 31) & 0x7fffffff); return __builtin_bit_cast(float, b); }
__device__ __forceinline__ float gelu_tanh(float x) { const float t = 0.7978845608028654f * (x + 0.044715f * x * x * x); return 0.5f * x * (1.0f + tanhf(t)); }


constexpr int RC = 64, RSEG = 8, RSEGLEN = S / RSEG, RNCH = RSEGLEN / RC;
constexpr int QS_OFF = 0, QS_STRIDE = 528, KS_STRIDE = 544, KS_OFF = 33792, VS_OFF = 68608, VS_STRIDE = 288, PS_OFF = 87040, PS_STRIDE = 144;
static_assert(KS_OFF == QS_OFF + 64 * QS_STRIDE && VS_OFF == KS_OFF + 64 * KS_STRIDE && PS_OFF == VS_OFF + 64 * VS_STRIDE && PS_OFF + 64 * PS_STRIDE <= 98304, "retention LDS layout");
typedef short s16x4 __attribute__((ext_vector_type(4)));
__device__ __forceinline__ bf16x8 tr_frag(LAS unsigned char* base, int stride, int lane) {
    const int g4 = lane >> 4, q = (lane & 15) >> 2, p = lane & 3;
    LAS unsigned char* a0 = base + (4 * g4 + q) * stride + 8 * p;
    const s16x4 lo = __builtin_amdgcn_ds_read_tr16_b64_v4i16((LAS s16x4*)a0);
    const s16x4 hi = __builtin_amdgcn_ds_read_tr16_b64_v4i16((LAS s16x4*)(a0 + 16 * stride));
    return __builtin_shufflevector(lo, hi, 0, 1, 2, 3, 4, 5, 6, 7);
}
constexpr int TS_OFF = 98304;
constexpr int NHP = 4 * NE;
__device__ __forceinline__ const float* tab_src(const float* pu, const float* pv, int p) { return ((p >= 2 * NE) ? pv : pu) + (size_t)(p & (2 * NE - 1)) * 1024; }
__device__ __forceinline__ unsigned char* tab_dst(unsigned char* ut, unsigned char* vt, int p) { return ((p >= 2 * NE) ? vt : ut) + (size_t)(p & (2 * NE - 1)) * 512; }
__device__ __forceinline__ unsigned char* tab_lane_dst(unsigned char* ut, unsigned char* vt, int p, int l) {
#if PEER_VSPLIT
    if (p >= 2 * NE) { const int r2 = p & (2 * NE - 1), off = (r2 & 1) * 512 + 8 * l; return vt + (size_t)(off >> 7) * ((size_t)NE * 128) + (size_t)(r2 >> 1) * 128 + (off & 127); }
#endif
    return tab_dst(ut, vt, p) + 8 * l;
}
__device__ __forceinline__ void tab4_half_store(const f32x4 (&xv)[4], float scl, unsigned char* dst) {
    unsigned w0 = 0u, w1 = 0u;
#define TAB4_Q(w_, q_, s0_, s1_) do { \
        const float e0_ = __builtin_amdgcn_fmed3f(xv[q_][0] * scl, -6.0f, 6.0f), e1_ = __builtin_amdgcn_fmed3f(xv[q_][1] * scl, -6.0f, 6.0f); \
        const float e2_ = __builtin_amdgcn_fmed3f(xv[q_][2] * scl, -6.0f, 6.0f), e3_ = __builtin_amdgcn_fmed3f(xv[q_][3] * scl, -6.0f, 6.0f); \
        w_ = __builtin_amdgcn_cvt_scalef32_pk_fp4_f32(w_, e0_, e1_, 1.0f, s0_); w_ = __builtin_amdgcn_cvt_scalef32_pk_fp4_f32(w_, e2_, e3_, 1.0f, s1_); } while (0)
    TAB4_Q(w0, 0, 0, 1); TAB4_Q(w0, 1, 2, 3); TAB4_Q(w1, 2, 0, 1); TAB4_Q(w1, 3, 2, 3);
#undef TAB4_Q
    u32x2 o; o.x = w0; o.y = w1; *(u32x2*)dst = o;
}
__device__ __forceinline__ void tab_dma(const float* gsrc, unsigned lds_dst) {
    unsigned keep;
    asm volatile("s_mov_b32 %0, m0\n\ts_mov_b32 m0, %2\n\ts_nop 0\n\t"
                 "global_load_lds_dwordx4 %1, off nt\n\tglobal_load_lds_dwordx4 %1, off offset:1024 nt\n\t"
                 "global_load_lds_dwordx4 %1, off offset:2048 nt\n\tglobal_load_lds_dwordx4 %1, off offset:3072 nt\n\t"
                 "s_mov_b32 m0, %0" : "=&s"(keep) : "v"(gsrc), "s"(lds_dst) : "memory");
}
template <bool FULL>
__device__ __forceinline__ int ret_pass(LAS unsigned char* lds, const bf16_t* qb, const bf16_t* kb, bf16_t* vb, float* Lbuf, int unit, int tid, int lane, int wave,
                                        const float* tj_pu, const float* tj_pv, unsigned char* tj_ut, unsigned char* tj_vt, float tj_su, float tj_sv, int tj_p, int tj_step) {
    const int h = unit >> 5, vq = (unit >> 3) & 3, g = unit & 7;
    if (!FULL && g == RSEG - 1) return tj_p;
    const int fr = lane & 15, g4 = lane >> 4;
    constexpr bool TJ = FULL && (TAB_IN_RET != 0);
    const unsigned ts_lds = (unsigned)__builtin_amdgcn_readfirstlane((int)(unsigned)(size_t)(lds + TS_OFF + wave * 4096));
    if (TJ && tj_p < NHP) tab_dma(tab_src(tj_pu, tj_pv, tj_p) + 4 * lane, ts_lds);
    const float lg = log2f(1.0f - exp2f(-5.0f - (float)h));
    const float gC = exp2f(64.0f * lg), gsc = exp2f(-64.0f * lg);
    float kd[4];
#pragma unroll
    for (int i = 0; i < 4; ++i) kd[i] = exp2f((float)(63 - ((tid >> 5) + 16 * i)) * lg);
    f32x4 st[16];
#pragma unroll
    for (int dt = 0; dt < 16; ++dt) st[dt] = (f32x4){0.f, 0.f, 0.f, 0.f};
    if (FULL) {
        const float gS = exp2f((float)RSEGLEN * lg);
        for (int gp = 0; gp < g; ++gp) {
            const f32x4* Lp = (const f32x4*)Lbuf + ((size_t)(((gp * 8 + h) * 4 + vq) * 8 + wave) * 16) * 64 + lane;
            f32x4 tmp[16];
#pragma unroll
            for (int dt = 0; dt < 16; ++dt) tmp[dt] = Lp[dt * 64];
            __builtin_amdgcn_sched_barrier(0);
#pragma unroll
            for (int dt = 0; dt < 16; ++dt) st[dt] = st[dt] * gS + tmp[dt];
        }
    }
    const int tbase = g * RSEGLEN;
    const bf16_t* qg = qb + (size_t)(tbase + (tid >> 5)) * 2048 + h * 256 + (tid & 31) * 8;
    const bf16_t* kg = kb + (size_t)(tbase + (tid >> 5)) * 2048 + h * 256 + (tid & 31) * 8;
    const bf16_t* vg = vb + (size_t)(tbase + (tid >> 4)) * 4096 + h * 512 + vq * 128 + (tid & 15) * 8;
    u32x4 pq[4], pk[4], pv[2];
    if (FULL) {
#pragma unroll
        for (int i = 0; i < 4; ++i) pq[i] = *(const u32x4*)(qg + (size_t)(16 * i) * 2048);
    }
#pragma unroll
    for (int i = 0; i < 4; ++i) pk[i] = *(const u32x4*)(kg + (size_t)(16 * i) * 2048);
#pragma unroll
    for (int i = 0; i < 2; ++i) pv[i] = *(const u32x4*)(vg + (size_t)(32 * i) * 4096);
    for (int c = 0; c < RNCH; ++c) {
        if (FULL) {
#pragma unroll
            for (int i = 0; i < 4; ++i) *(LAS u32x4*)(lds + QS_OFF + ((tid >> 5) + 16 * i) * QS_STRIDE + (tid & 31) * 16) = pq[i];
        }
#pragma unroll
        for (int i = 0; i < 4; ++i) {
            const float kc = kd[i];
            u32x4 w; w.x = pk2(bf_lo(pk[i].x) * kc, bf_hi(pk[i].x) * kc); w.y = pk2(bf_lo(pk[i].y) * kc, bf_hi(pk[i].y) * kc); w.z = pk2(bf_lo(pk[i].z) * kc, bf_hi(pk[i].z) * kc); w.w = pk2(bf_lo(pk[i].w) * kc, bf_hi(pk[i].w) * kc);
            *(LAS u32x4*)(lds + KS_OFF + ((tid >> 5) + 16 * i) * KS_STRIDE + (tid & 31) * 16) = w;
        }
#pragma unroll
        for (int i = 0; i < 2; ++i) *(LAS u32x4*)(lds + VS_OFF + ((tid >> 4) + 32 * i) * VS_STRIDE + (tid & 15) * 16) = pv[i];
        if (TJ) {
            __builtin_amdgcn_sched_barrier(0);
            asm volatile("s_waitcnt vmcnt(0)" ::: "memory");
            if (tj_p < NHP) {
                f32x4 xv[4];
#pragma unroll
                for (int q = 0; q < 4; ++q) xv[q] = *(const LAS f32x4*)(lds + TS_OFF + wave * 4096 + 64 * lane + 16 * q);
                tab4_half_store(xv, (tj_p >= 2 * NE) ? tj_sv : tj_su, tab_lane_dst(tj_ut, tj_vt, tj_p, lane));
            }
            tj_p += tj_step;
            if (c + 1 < RNCH && tj_p < NHP) tab_dma(tab_src(tj_pu, tj_pv, tj_p) + 4 * lane, ts_lds);
            __builtin_amdgcn_sched_barrier(0);
        }
        if (c + 1 < RNCH) {
            const size_t adv = (size_t)(c + 1) * RC;
            if (FULL) {
#pragma unroll
                for (int i = 0; i < 4; ++i) pq[i] = *(const u32x4*)(qg + (adv + 16 * i) * 2048);
            }
#pragma unroll
            for (int i = 0; i < 4; ++i) pk[i] = *(const u32x4*)(kg + (adv + 16 * i) * 2048);
#pragma unroll
            for (int i = 0; i < 2; ++i) pv[i] = *(const u32x4*)(vg + (adv + 32 * i) * 4096);
        }
        __syncthreads();
        if (FULL) {
            const int rt = wave >> 1, ctb = (wave & 1) * 2;
            f32x4 pacc0 = (f32x4){0.f, 0.f, 0.f, 0.f}, pacc1 = (f32x4){0.f, 0.f, 0.f, 0.f};
#pragma unroll
            for (int kh = 0; kh < 2; ++kh) {
                bf16x8 qa[4], kb0[4], kb1[4];
#pragma unroll
                for (int k2 = 0; k2 < 4; ++k2) { const int ks = 4 * kh + k2;
                    qa[k2] = *(const LAS bf16x8*)(lds + QS_OFF + (16 * rt + fr) * QS_STRIDE + 64 * ks + 16 * g4);
                    kb0[k2] = *(const LAS bf16x8*)(lds + KS_OFF + (16 * ctb + fr) * KS_STRIDE + 64 * ks + 16 * g4);
                    kb1[k2] = *(const LAS bf16x8*)(lds + KS_OFF + (16 * ctb + 16 + fr) * KS_STRIDE + 64 * ks + 16 * g4); }
                __builtin_amdgcn_sched_barrier(0);
#pragma unroll
                for (int k2 = 0; k2 < 4; ++k2) {
                    pacc0 = __builtin_amdgcn_mfma_f32_16x16x32_bf16(qa[k2], kb0[k2], pacc0, 0, 0, 0);
                    pacc1 = __builtin_amdgcn_mfma_f32_16x16x32_bf16(qa[k2], kb1[k2], pacc1, 0, 0, 0);
                }
                __builtin_amdgcn_sched_barrier(0);
            }
#pragma unroll
            for (int cc = 0; cc < 2; ++cc) {
                const int j = 16 * (ctb + cc) + fr;
#pragma unroll
                for (int r = 0; r < 4; ++r) {
                    const int i = 16 * rt + 4 * g4 + r;
                    const float pa = cc ? pacc1[r] : pacc0[r];
                    const float pvv = (j <= i) ? pa * gsc : 0.f;
                    *(LAS unsigned short*)(lds + PS_OFF + i * PS_STRIDE + 2 * j) = (unsigned short)(pk2(pvv, 0.f) & 0xffffu);
                }
            }
        }
        bf16x8 vf[2];
        vf[0] = tr_frag(lds + VS_OFF + 32 * wave, VS_STRIDE, lane);
        vf[1] = tr_frag(lds + VS_OFF + 32 * VS_STRIDE + 32 * wave, VS_STRIDE, lane);
        bf16x8 kf[3][2][2];
#define RET_LDK(buf, dtb) do { _Pragma("unroll") for (int d2 = 0; d2 < 2; ++d2) _Pragma("unroll") for (int ks = 0; ks < 2; ++ks) \
            kf[buf][d2][ks] = tr_frag(lds + KS_OFF + 32 * ks * KS_STRIDE + 32 * ((dtb) + d2), KS_STRIDE, lane); } while (0)
#define RET_UPD(buf, dtb) do { _Pragma("unroll") for (int d2 = 0; d2 < 2; ++d2) st[(dtb) + d2] = st[(dtb) + d2] * gC; \
            _Pragma("unroll") for (int ks = 0; ks < 2; ++ks) _Pragma("unroll") for (int d2 = 0; d2 < 2; ++d2) \
                st[(dtb) + d2] = __builtin_amdgcn_mfma_f32_16x16x32_bf16(kf[buf][d2][ks], vf[ks], st[(dtb) + d2], 0, 0, 0); } while (0)
        if (FULL) {
            f32x4 o[4];
#pragma unroll
            for (int rt = 0; rt < 4; ++rt) o[rt] = (f32x4){0.f, 0.f, 0.f, 0.f};
            u32x4 qf[3][4];
            LAS unsigned char* const qlo = (LAS unsigned char*)(size_t)(unsigned)launder((int)(unsigned)(size_t)(lds + QS_OFF + fr * QS_STRIDE + 8 * g4));
            LAS unsigned char* const qhi = (LAS unsigned char*)(size_t)(unsigned)launder((int)(unsigned)(size_t)(lds + QS_OFF + fr * QS_STRIDE + 8 * g4 + 32));
#define RET_LDQ(buf, ks) do { _Pragma("unroll") for (int rt = 0; rt < 4; ++rt) { \
                const u32x2 a0 = *(const LAS u32x2*)(qlo + 16 * rt * QS_STRIDE + 64 * (ks)); \
                const u32x2 a1 = *(const LAS u32x2*)(qhi + 16 * rt * QS_STRIDE + 64 * (ks)); \
                qf[buf][rt].x = a0.x; qf[buf][rt].y = a0.y; qf[buf][rt].z = a1.x; qf[buf][rt].w = a1.y; } } while (0)
#define RET_CROSS(buf, ks) do { \
                u32x4 sb; sb.x = pk2(st[2 * (ks)][0], st[2 * (ks)][1]); sb.y = pk2(st[2 * (ks)][2], st[2 * (ks)][3]); sb.z = pk2(st[2 * (ks) + 1][0], st[2 * (ks) + 1][1]); sb.w = pk2(st[2 * (ks) + 1][2], st[2 * (ks) + 1][3]); \
                const bf16x8 sfrag = __builtin_bit_cast(bf16x8, sb); \
                _Pragma("unroll") for (int rt = 0; rt < 4; ++rt) o[rt] = __builtin_amdgcn_mfma_f32_16x16x32_bf16(__builtin_bit_cast(bf16x8, qf[buf][rt]), sfrag, o[rt], 0, 0, 0); } while (0)
            RET_LDQ(0, 0); __builtin_amdgcn_sched_barrier(0); RET_LDQ(1, 1);
            __builtin_amdgcn_sched_barrier(0);
            RET_LDQ(2, 2); RET_CROSS(0, 0); __builtin_amdgcn_sched_barrier(0);
            RET_LDQ(0, 3); RET_CROSS(1, 1); __builtin_amdgcn_sched_barrier(0);
            RET_LDQ(1, 4); RET_CROSS(2, 2); __builtin_amdgcn_sched_barrier(0);
            RET_LDQ(2, 5); RET_CROSS(0, 3); __builtin_amdgcn_sched_barrier(0);
            RET_LDQ(0, 6); RET_CROSS(1, 4); __builtin_amdgcn_sched_barrier(0);
            RET_LDQ(1, 7); RET_CROSS(2, 5); __builtin_amdgcn_sched_barrier(0);
            RET_CROSS(0, 6); __builtin_amdgcn_sched_barrier(0);
            RET_CROSS(1, 7); __builtin_amdgcn_sched_barrier(0);
            __syncthreads();
            {
                bf16x8 pf[4][2];
                LAS unsigned char* const plo = (LAS unsigned char*)(size_t)(unsigned)launder((int)(unsigned)(size_t)(lds + PS_OFF + fr * PS_STRIDE + 8 * g4));
                LAS unsigned char* const phi = (LAS unsigned char*)(size_t)(unsigned)launder((int)(unsigned)(size_t)(lds + PS_OFF + fr * PS_STRIDE + 8 * g4 + 32));
#pragma unroll
                for (int ks = 0; ks < 2; ++ks) {
#pragma unroll
                    for (int rt = 0; rt < 4; ++rt) {
                        const u32x2 a0 = *(const LAS u32x2*)(plo + 16 * rt * PS_STRIDE + 64 * ks);
                        const u32x2 a1 = *(const LAS u32x2*)(phi + 16 * rt * PS_STRIDE + 64 * ks);
                        u32x4 w_; w_.x = a0.x; w_.y = a0.y; w_.z = a1.x; w_.w = a1.y; pf[rt][ks] = __builtin_bit_cast(bf16x8, w_);
                    }
                    __builtin_amdgcn_sched_barrier(0);
                }
                __builtin_amdgcn_sched_barrier(0);
#pragma unroll
                for (int ks = 0; ks < 2; ++ks)
#pragma unroll
                    for (int rt = 0; rt < 4; ++rt) o[rt] = __builtin_amdgcn_mfma_f32_16x16x32_bf16(pf[rt][ks], vf[ks], o[rt], 0, 0, 0);
            }
            __builtin_amdgcn_sched_barrier(0);
            RET_LDK(0, 0); RET_LDK(1, 2);
            __builtin_amdgcn_sched_barrier(0);
#undef RET_LDQ
#undef RET_CROSS
            const float gb = exp2f((float)(4 * g4 + 1) * lg), g1 = exp2f(lg), g16 = exp2f(16.0f * lg);
            bf16_t* yp = vb + (size_t)(tbase + c * RC) * 4096 + h * 512 + vq * 128 + 16 * wave + fr;
            float frt = gb;
#pragma unroll
            for (int rt = 0; rt < 4; ++rt) {
                float f = frt;
#pragma unroll
                for (int r = 0; r < 4; ++r) { yp[(size_t)(16 * rt + 4 * g4 + r) * 4096] = (bf16_t)(pk2(o[rt][r] * f, 0.f) & 0xffffu); f *= g1; }
                frt *= g16;
            }
        } else {
            RET_LDK(0, 0); RET_LDK(1, 2);
        }
        __builtin_amdgcn_sched_barrier(0);
        RET_LDK(2, 4); RET_UPD(0, 0); __builtin_amdgcn_sched_barrier(0);
        RET_LDK(0, 6); RET_UPD(1, 2); __builtin_amdgcn_sched_barrier(0);
        RET_LDK(1, 8); RET_UPD(2, 4); __builtin_amdgcn_sched_barrier(0);
        RET_LDK(2, 10); RET_UPD(0, 6); __builtin_amdgcn_sched_barrier(0);
        RET_LDK(0, 12); RET_UPD(1, 8); __builtin_amdgcn_sched_barrier(0);
        RET_LDK(1, 14); RET_UPD(2, 10); __builtin_amdgcn_sched_barrier(0);
        RET_UPD(0, 12); RET_UPD(1, 14);
#undef RET_LDK
#undef RET_UPD
        __syncthreads();
    }
    if (!FULL) {
        f32x4* Lp = (f32x4*)Lbuf + ((size_t)(((g * 8 + h) * 4 + vq) * 8 + wave) * 16) * 64 + lane;
#pragma unroll
        for (int dt = 0; dt < 16; ++dt) Lp[dt * 64] = st[dt];
    }
    return tj_p;
}

__device__ __forceinline__ void ret_pass1(LAS unsigned char* lds, const bf16_t* kb, const bf16_t* vb, float* Lbuf, int unit, int tid, int lane, int wave) {
    const int h = unit >> 5, vq = (unit >> 3) & 3, g = unit & 7;
    if (g == RSEG - 1) return;
    const float lg = log2f(1.0f - exp2f(-5.0f - (float)h));
    const float gC = exp2f(64.0f * lg);
    float kd[4];
#pragma unroll
    for (int i = 0; i < 4; ++i) kd[i] = exp2f((float)(63 - ((tid >> 5) + 16 * i)) * lg);
    f32x4 st[16];
#pragma unroll
    for (int dt = 0; dt < 16; ++dt) st[dt] = (f32x4){0.f, 0.f, 0.f, 0.f};
    const int tbase = g * RSEGLEN;
    const bf16_t* kg = kb + (size_t)(tbase + (tid >> 5)) * 2048 + h * 256 + (tid & 31) * 8;
    const bf16_t* vg = vb + (size_t)(tbase + (tid >> 4)) * 4096 + h * 512 + vq * 128 + (tid & 15) * 8;
    u32x4 pkA[4], pvA[2], pkB[4], pvB[2];
#define P1_PREFETCH(pk_, pv_, cc_) do { const size_t adv_ = (size_t)(cc_) * RC; \
        _Pragma("unroll") for (int i = 0; i < 4; ++i) pk_[i] = *(const u32x4*)(kg + (adv_ + 16 * i) * 2048); \
        _Pragma("unroll") for (int i = 0; i < 2; ++i) pv_[i] = *(const u32x4*)(vg + (adv_ + 32 * i) * 4096); } while (0)
#define P1_LDK(buf, dtb) do { _Pragma("unroll") for (int d2 = 0; d2 < 2; ++d2) _Pragma("unroll") for (int ks = 0; ks < 2; ++ks) \
        kf[buf][d2][ks] = tr_frag(lds + KS_OFF + 32 * ks * KS_STRIDE + 32 * ((dtb) + d2), KS_STRIDE, lane); } while (0)
#define P1_UPD(buf, dtb) do { _Pragma("unroll") for (int d2 = 0; d2 < 2; ++d2) st[(dtb) + d2] = st[(dtb) + d2] * gC; \
        _Pragma("unroll") for (int ks = 0; ks < 2; ++ks) _Pragma("unroll") for (int d2 = 0; d2 < 2; ++d2) \
            st[(dtb) + d2] = __builtin_amdgcn_mfma_f32_16x16x32_bf16(kf[buf][d2][ks], vf[ks], st[(dtb) + d2], 0, 0, 0); } while (0)
#define P1_CHUNK(pk_, pv_, cpre_) do { \
        _Pragma("unroll") for (int i = 0; i < 4; ++i) { const float kc = kd[i]; \
            u32x4 w; w.x = pk2(bf_lo(pk_[i].x) * kc, bf_hi(pk_[i].x) * kc); w.y = pk2(bf_lo(pk_[i].y) * kc, bf_hi(pk_[i].y) * kc); w.z = pk2(bf_lo(pk_[i].z) * kc, bf_hi(pk_[i].z) * kc); w.w = pk2(bf_lo(pk_[i].w) * kc, bf_hi(pk_[i].w) * kc); \
            *(LAS u32x4*)(lds + KS_OFF + ((tid >> 5) + 16 * i) * KS_STRIDE + (tid & 31) * 16) = w; } \
        _Pragma("unroll") for (int i = 0; i < 2; ++i) *(LAS u32x4*)(lds + VS_OFF + ((tid >> 4) + 32 * i) * VS_STRIDE + (tid & 15) * 16) = pv_[i]; \
        if ((cpre_) < RNCH) P1_PREFETCH(pk_, pv_, cpre_); \
        __syncthreads(); \
        bf16x8 vf[2]; vf[0] = tr_frag(lds + VS_OFF + 32 * wave, VS_STRIDE, lane); vf[1] = tr_frag(lds + VS_OFF + 32 * VS_STRIDE + 32 * wave, VS_STRIDE, lane); \
        bf16x8 kf[3][2][2]; \
        P1_LDK(0, 0); P1_LDK(1, 2); __builtin_amdgcn_sched_barrier(0); \
        P1_LDK(2, 4); P1_UPD(0, 0); __builtin_amdgcn_sched_barrier(0); \
        P1_LDK(0, 6); P1_UPD(1, 2); __builtin_amdgcn_sched_barrier(0); \
        P1_LDK(1, 8); P1_UPD(2, 4); __builtin_amdgcn_sched_barrier(0); \
        P1_LDK(2, 10); P1_UPD(0, 6); __builtin_amdgcn_sched_barrier(0); \
        P1_LDK(0, 12); P1_UPD(1, 8); __builtin_amdgcn_sched_barrier(0); \
        P1_LDK(1, 14); P1_UPD(2, 10); __builtin_amdgcn_sched_barrier(0); \
        P1_UPD(0, 12); P1_UPD(1, 14); \
        __syncthreads(); } while (0)
    P1_PREFETCH(pkA, pvA, 0); P1_PREFETCH(pkB, pvB, 1);
    for (int c = 0; c < RNCH; c += 2) { P1_CHUNK(pkA, pvA, c + 2); P1_CHUNK(pkB, pvB, c + 3); }
#undef P1_PREFETCH
#undef P1_LDK
#undef P1_UPD
#undef P1_CHUNK
    f32x4* Lp = (f32x4*)Lbuf + ((size_t)(((g * 8 + h) * 4 + vq) * 8 + wave) * 16) * 64 + lane;
#pragma unroll
    for (int dt = 0; dt < 16; ++dt) Lp[dt * 64] = st[dt];
}

__global__ void __launch_bounds__(512, 2) mk_fwd(Args a) {
    extern __shared__ __attribute__((aligned(16))) unsigned char lds_raw[];
    LAS unsigned char* lds = (LAS unsigned char*)lds_raw;
    const int tid = threadIdx.x, lane = tid & 63, wave = __builtin_amdgcn_readfirstlane(tid >> 6);
    const int G = gridDim.x, gw = blockIdx.x * 8 + wave, NGW = G * 8;
    unsigned char* ws = a.ws; unsigned char* dob = (unsigned char*)a.out;
    long long* modacc = (long long*)(ws + WS_CTL);
    bf16_t* WoutT = (bf16_t*)(ws + WS_WOUT); bf16_t* WqsT = (bf16_t*)(ws + WS_WQS); bf16_t* WinT = (bf16_t*)(ws + WS_WIN);
    bf16_t* pooled = (bf16_t*)(ws + WS_POOLED); bf16_t* upool = (bf16_t*)(ws + WS_UPOOL); bf16_t* merged = (bf16_t*)(ws + WS_MERGED);
    bf16_t* qb = (bf16_t*)(ws + WS_Q); bf16_t* kb = (bf16_t*)(ws + WS_K); bf16_t* vb = (bf16_t*)(ws + WS_V);
    unsigned char* utab = ws + WS_UTAB; unsigned char* vtab = ws + WS_VTAB;
    float* scores = (float*)(ws + WS_SCORES);
    unsigned char* gret = ws + WS_GRET; bf16_t* fn = (bf16_t*)(ws + WS_FN);
    unsigned char* ret8 = ws + WS_Q;
    unsigned char* fn8 = ws + WS_HN8;
    unsigned char* hn8 = ws + WS_HN8; unsigned char* WinT8 = ws + WS_WIN + (size_t)NB16 * D * 2;
    unsigned char* sap = ws + WS_SAP; unsigned char* sar = ws + WS_SAR;
    bf16_t* hn = (bf16_t*)(dob + DO_HN); float* rcos = (float*)(dob + DO_RCOS); float* rsin = (float*)(dob + DO_RSIN);
    float* Lbuf = (float*)(dob + DO_HN);
    bf16_t* WpcT = (bf16_t*)(dob + DO_WPC); bf16_t* PretT = (bf16_t*)(dob + DO_PRET);
    const int lo = a.ph_lo, hi = a.ph_hi;
#define IN(k) (lo <= (k) && (k) < hi)
#define PH_IDS const int lane = launder(lane_id()), tid = wave * 64 + lane
    volatile LAS unsigned* misc = (volatile LAS unsigned*)(lds + LDS_BYTES - 16);
    if (tid < 4) misc[tid] = 0u;
    __syncthreads();
    XcdBarrier xbar; xbar.bar = (unsigned*)(ws + WS_CTL + CTL_BAR); xbar.x = 0; xbar.st = misc; xbar.wave = wave;
    if (hi - lo > 1) xbar = xcd_barrier_post((unsigned*)(ws + WS_CTL + CTL_BAR), misc, wave);
#define SEAM(k) do { if (lo <= (k) && (k) + 1 < hi) xcd_barrier(xbar); } while (0)

    float* pscale = (float*)(ws + WS_CTL + CTL_SCALE);
    if (IN(0)) { PH_IDS;
        if (blockIdx.x == 0) {
            float su = 0.f, sv = 0.f;
#pragma unroll
            for (int q = 0; q < 8; ++q) { const f32x4 uq = *(const f32x4*)(a.peer_u + tid * 32 + 4 * q), vq = *(const f32x4*)(a.peer_v + tid * 32 + 4 * q);
                su += uq.x * uq.x + uq.y * uq.y + uq.z * uq.z + uq.w * uq.w; sv += vq.x * vq.x + vq.y * vq.y + vq.z * vq.z + vq.w * vq.w; }
            su = wave_sum(su); sv = wave_sum(sv);
            LAS float* red = (LAS float*)lds;
            if (lane == 0) { red[wave] = su; red[8 + wave] = sv; }
            __syncthreads();
            if (tid == 0) { float tu = 0.f, tv = 0.f; for (int w = 0; w < 8; ++w) { tu += red[w]; tv += red[8 + w]; }
                const float ru = sqrtf(tu * (1.0f / 16384.0f)) + 1e-30f, rv = sqrtf(tv * (1.0f / 16384.0f)) + 1e-30f;
                pscale[0] = 2.0f / ru; pscale[1] = 2.0f / rv; pscale[2] = ru * 0.5f; pscale[3] = rv * 0.5f; }
            __syncthreads();
        }
        LAS float* scr = (LAS float*)(lds + wave * 16384);
        volatile LAS int* wq = (volatile LAS int*)(lds + 8 * 16384);
        if (tid == 0) *wq = 0;
        __syncthreads();
        if (wave < 4) for (int it = blockIdx.x * 4 + wave; it < 1024; it += G * 4) {
            const int g = it >> 8, cb = (it >> 5) & 7, nb = it & 31, l15 = lane & 15, l4 = lane >> 4;
            f32x4 acc[4][4];
#pragma unroll
            for (int mi = 0; mi < 4; ++mi)
#pragma unroll
                for (int ni = 0; ni < 4; ++ni) acc[mi][ni] = (f32x4){0.f, 0.f, 0.f, 0.f};
            const float* pa = a.pool_w + ((size_t)g * 512 + cb * 64 + l15) * 512 + 8 * l4;
            const float* pb = a.w_branch_pool + (size_t)(g * 512 + 8 * l4) * D + nb * 64 + l15;
            const float* ps = a.pool_scale + g * 512 + 8 * l4;
#pragma unroll 2
            for (int d0 = 0; d0 < 512; d0 += 32) {
                bf16x8 af[4], bfr[4];
                const f32x4 s0 = *(const f32x4*)(ps + d0), s1 = *(const f32x4*)(ps + d0 + 4);
                float braw[4][8];
#pragma unroll
                for (int ni = 0; ni < 4; ++ni)
#pragma unroll
                    for (int e = 0; e < 8; ++e) braw[ni][e] = pb[(size_t)(d0 + e) * D + ni * 16];
#pragma unroll
                for (int mi = 0; mi < 4; ++mi) { const f32x4 x0 = *(const f32x4*)(pa + (size_t)mi * 16 * 512 + d0), x1 = *(const f32x4*)(pa + (size_t)mi * 16 * 512 + d0 + 4);
                    u32x4 w; w.x = pk2(x0.x, x0.y); w.y = pk2(x0.z, x0.w); w.z = pk2(x1.x, x1.y); w.w = pk2(x1.z, x1.w); af[mi] = __builtin_bit_cast(bf16x8, w); }
#pragma unroll
                for (int ni = 0; ni < 4; ++ni) { u32x4 w; w.x = pk2(braw[ni][0] * s0.x, braw[ni][1] * s0.y); w.y = pk2(braw[ni][2] * s0.z, braw[ni][3] * s0.w); w.z = pk2(braw[ni][4] * s1.x, braw[ni][5] * s1.y); w.w = pk2(braw[ni][6] * s1.z, braw[ni][7] * s1.w);
                    bfr[ni] = __builtin_bit_cast(bf16x8, w); }
#pragma unroll
                for (int mi = 0; mi < 4; ++mi)
#pragma unroll
                    for (int ni = 0; ni < 4; ++ni) acc[mi][ni] = __builtin_amdgcn_mfma_f32_16x16x32_bf16(af[mi], bfr[ni], acc[mi][ni], 0, 0, 0);
            }
#pragma unroll
            for (int mi = 0; mi < 4; ++mi)
#pragma unroll
                for (int ni = 0; ni < 4; ++ni) { u32x2 w; w.x = pk2(acc[mi][ni][0], acc[mi][ni][1]); w.y = pk2(acc[mi][ni][2], acc[mi][ni][3]);
                    *(u32x2*)(WpcT + (size_t)(nb * 64 + ni * 16 + l15) * D + g * 512 + cb * 64 + mi * 16 + 4 * l4) = w; }
        }
        if (wave < 4) for (int it = blockIdx.x * 4 + wave; it < 1024; it += G * 4) {
            const int hp = it >> 6, nb = (it >> 5) & 1, db = it & 31, l15 = lane & 15, l4 = lane >> 4;
            f32x4 acc[4][4];
#pragma unroll
            for (int mi = 0; mi < 4; ++mi)
#pragma unroll
                for (int ni = 0; ni < 4; ++ni) acc[mi][ni] = (f32x4){0.f, 0.f, 0.f, 0.f};
            const float* pa = a.peer_w_query + (size_t)(db * 64 + l15) * D + hp * 128 + 8 * l4;
            const float* pb = a.peer_sub_keys + ((size_t)hp * 128 + nb * 64 + l15) * 128 + 8 * l4;
#pragma unroll
            for (int c0 = 0; c0 < 128; c0 += 32) {
                bf16x8 af[4], bfr[4];
#pragma unroll
                for (int mi = 0; mi < 4; ++mi) { const f32x4 x0 = *(const f32x4*)(pa + (size_t)mi * 16 * D + c0), x1 = *(const f32x4*)(pa + (size_t)mi * 16 * D + c0 + 4);
                    u32x4 w; w.x = pk2(x0.x, x0.y); w.y = pk2(x0.z, x0.w); w.z = pk2(x1.x, x1.y); w.w = pk2(x1.z, x1.w); af[mi] = __builtin_bit_cast(bf16x8, w); }
#pragma unroll
                for (int ni = 0; ni < 4; ++ni) { const f32x4 x0 = *(const f32x4*)(pb + (size_t)ni * 16 * 128 + c0), x1 = *(const f32x4*)(pb + (size_t)ni * 16 * 128 + c0 + 4);
                    u32x4 w; w.x = pk2(x0.x, x0.y); w.y = pk2(x0.z, x0.w); w.z = pk2(x1.x, x1.y); w.w = pk2(x1.z, x1.w); bfr[ni] = __builtin_bit_cast(bf16x8, w); }
#pragma unroll
                for (int mi = 0; mi < 4; ++mi)
#pragma unroll
                    for (int ni = 0; ni < 4; ++ni) acc[mi][ni] = __builtin_amdgcn_mfma_f32_16x16x32_bf16(af[mi], bfr[ni], acc[mi][ni], 0, 0, 0);
            }
#pragma unroll
            for (int mi = 0; mi < 4; ++mi)
#pragma unroll
                for (int ni = 0; ni < 4; ++ni) { u32x2 w; w.x = pk2(acc[mi][ni][0], acc[mi][ni][1]); w.y = pk2(acc[mi][ni][2], acc[mi][ni][3]);
                    *(u32x2*)(WqsT + (size_t)(hp * 128 + nb * 64 + ni * 16 + l15) * D + db * 64 + mi * 16 + 4 * l4) = w; }
        }
        constexpr int I_IN = (D / 64) * (NIN / 32), I_PR = (VW / 64) * (D / 32), I_WO = (D / 64) * (D / 32);
        constexpr int NT_ITEMS = (I_IN + I_PR + I_WO) / 256, NG_ITEMS = 64 * 48 / 256;
        if (G == 256) {
            for (;;) {
                int n = 0;
                if (lane == 0) n = __hip_atomic_fetch_add((LAS int*)wq, 1, __ATOMIC_RELAXED, __HIP_MEMORY_SCOPE_WORKGROUP);
                n = __builtin_amdgcn_readfirstlane(n);
                if (n >= NT_ITEMS + NG_ITEMS) break;
                if (n < NT_ITEMS) {
                    int r = (int)blockIdx.x * 8 + (n & 7) + 2048 * (n >> 3);
                    if (r < I_IN) { transpose_item(a.w_in, D, NIN, WinT, scr, r, lane, NB16, WinT8); continue; } r -= I_IN;
                    if (r < I_PR) { transpose_item(a.w_branch_ret, VW, D, PretT, scr, r, lane, 0, (unsigned char*)PretT); continue; } r -= I_PR;
                    transpose_item(a.w_out, D, D, WoutT, scr, r, lane);
                } else {
                    const int it = (int)blockIdx.x + 256 * (n - NT_ITEMS);
                    const int kc = it / 48, nc = it % 48, k0 = kc * 32, nn = nc * 256 + lane * 4;
                    f32x4 acc = (f32x4){0.f, 0.f, 0.f, 0.f};
#pragma unroll
                    for (int kk = 0; kk < 32; ++kk) { const float cv = a.c[k0 + kk]; const float sv = cv * sigmoidf_(cv); acc += __builtin_nontemporal_load((const f32x4*)(a.w_ada + (size_t)(k0 + kk) * (6 * D) + nn)) * sv; }
#pragma unroll
                    for (int e = 0; e < 4; ++e) atomicAdd((unsigned long long*)(modacc + nn + e), (unsigned long long)(long long)__double2ll_rn((double)acc[e] * MOD_FX));
                }
            }
        } else
        for (int it = gw; it < I_IN + I_PR + I_WO; it += NGW) {
            int r = it;
            if (r < I_IN) { transpose_item(a.w_in, D, NIN, WinT, scr, r, lane, NB16, WinT8); continue; } r -= I_IN;
            if (r < I_PR) { transpose_item(a.w_branch_ret, VW, D, PretT, scr, r, lane, 0, (unsigned char*)PretT); continue; } r -= I_PR;
            transpose_item(a.w_out, D, D, WoutT, scr, r, lane);
        }
        const float rinv = powf(10000.0f, -(float)(2 * (tid & 127)) * (1.0f / 256.0f));
        for (int idx = blockIdx.x * 512 + tid; idx < S * 128; idx += G * 512) {
            const int t = idx >> 7;
            const float inv = rinv;
            const float ang = (float)a.positions[t] * inv;
            float sn, cs; sincosf(ang, &sn, &cs);
            rcos[idx] = cs; rsin[idx] = sn;
        }
        if (G != 256) for (int it = gw; it < 64 * 48; it += NGW) {
            const int kc = it / 48, nc = it % 48, k0 = kc * 32, n = nc * 256 + lane * 4;
            f32x4 acc = (f32x4){0.f, 0.f, 0.f, 0.f};
#pragma unroll
            for (int kk = 0; kk < 32; ++kk) { const float cv = a.c[k0 + kk]; const float sv = cv * sigmoidf_(cv); acc += *(const f32x4*)(a.w_ada + (size_t)(k0 + kk) * (6 * D) + n) * sv; }
#pragma unroll
            for (int e = 0; e < 4; ++e) atomicAdd((unsigned long long*)(modacc + n + e), (unsigned long long)(long long)__double2ll_rn((double)acc[e] * MOD_FX));
        }
    }
    SEAM(0);
    if (IN(1)) { PH_IDS;
        LAS float* ml = (LAS float*)lds;
        for (int i = launder(tid); i < 2 * D; i += 512) ml[i] = modval(modacc, a.b_ada, i);
        __syncthreads();
        for (int m = gw * 2; m < S; m += NGW * 2) norm_mod_row2<true>(a.x + (size_t)m * D, a.x + (size_t)(m + 1) * D, a.norm_mix_gain, ml, ml + D, hn + (size_t)m * D, hn + (size_t)(m + 1) * D, lane, hn8 + (size_t)m * D, hn8 + (size_t)(m + 1) * D);
    }
    SEAM(1);
    if (IN(2)) { PH_IDS;
        { pg8::Gemm g{hn, WinT, S, NB16, D}; pg8::StaticOrder so; so.init(S, NB16, G, (int)blockIdx.x);
          EpiG1<0> E{upool, qb, kb, vb, gret, sap, sar, rcos, rsin, 0};
          pg8::gemm_phase<EpiG1<0>>(lds, g, so, E, wave); }
        { pg8::Gemm g{(const bf16_t*)hn8, (const bf16_t*)WinT8, S, NIN - NB16, D}; pg8::StaticOrder so; so.init(S, NIN - NB16, G, (int)blockIdx.x);
          EpiG1<1> E{upool, qb, kb, vb, gret, sap, sar, rcos, rsin, NB16 / 256};
          pg8::gemm_phase<EpiG1<1>, true, true, true>(lds, g, so, E, wave); }
    }
    SEAM(2);
    if (IN(3)) { PH_IDS;
        for (int un = blockIdx.x; un < 256; un += G) ret_pass1(lds, kb, vb, Lbuf, un, tid, lane, wave);
        const bool skew = (G == 256); const bool idleb = (blockIdx.x & 7) == 7;
        const int wfirst = skew ? (idleb ? 5376 + ((int)(blockIdx.x >> 3) * 8 + wave) : (((int)(blockIdx.x >> 3) * 7 + (int)(blockIdx.x & 7)) * 8 + wave)) : gw;
        const int wstep = skew ? (idleb ? 256 : 1792) : NGW, wend = skew ? (idleb ? 8192 : 5376) : 8192;
        for (int wi = wfirst; wi < wend; wi += wstep) {
            const int idx = wi * 64 + lane;
            const int t0 = (idx >> 8) * 8, c8 = (idx & 255) * 8, grp = __builtin_amdgcn_readfirstlane(c8 >> 9);
            const bf16_t* up = upool + (size_t)t0 * 2048 + c8;
            bf16_t* op = pooled + (size_t)t0 * 2048 + c8;
#define POOL_W(W) do { u32x4 uv[W + 7]; _Pragma("unroll") for (int j = 0; j < W + 7; ++j) { const int tt = t0 - (W - 1) + j; uv[j] = (tt >= 0) ? *(const u32x4*)(up + ((long)j - (W - 1)) * 2048) : (u32x4){0u, 0u, 0u, 0u}; } \
                float sm[8]; _Pragma("unroll") for (int e = 0; e < 8; ++e) sm[e] = 0.f; \
                _Pragma("unroll") for (int j = 0; j < W - 1; ++j) { sm[0] += bf_lo(uv[j].x); sm[1] += bf_hi(uv[j].x); sm[2] += bf_lo(uv[j].y); sm[3] += bf_hi(uv[j].y); sm[4] += bf_lo(uv[j].z); sm[5] += bf_hi(uv[j].z); sm[6] += bf_lo(uv[j].w); sm[7] += bf_hi(uv[j].w); } \
                _Pragma("unroll") for (int i = 0; i < 8; ++i) { const u32x4 cu = uv[W - 1 + i]; \
                    const float cf[8] = {bf_lo(cu.x), bf_hi(cu.x), bf_lo(cu.y), bf_hi(cu.y), bf_lo(cu.z), bf_hi(cu.z), bf_lo(cu.w), bf_hi(cu.w)}; \
                    _Pragma("unroll") for (int e = 0; e < 8; ++e) sm[e] += cf[e]; \
                    const int cnt = (t0 + i + 1 < W) ? (t0 + i + 1) : W; const float inv = 1.0f / (float)cnt; \
                    u32x4 o; o.x = pk2(sm[0] * inv - cf[0], sm[1] * inv - cf[1]); o.y = pk2(sm[2] * inv - cf[2], sm[3] * inv - cf[3]); o.z = pk2(sm[4] * inv - cf[4], sm[5] * inv - cf[5]); o.w = pk2(sm[6] * inv - cf[6], sm[7] * inv - cf[7]); \
                    *(u32x4*)(op + (size_t)i * 2048) = o; \
                    const u32x4 ou = uv[i]; sm[0] -= bf_lo(ou.x); sm[1] -= bf_hi(ou.x); sm[2] -= bf_lo(ou.y); sm[3] -= bf_hi(ou.y); sm[4] -= bf_lo(ou.z); sm[5] -= bf_hi(ou.z); sm[6] -= bf_lo(ou.w); sm[7] -= bf_hi(ou.w); } } while (0)
            if (grp == 0) POOL_W(2); else if (grp == 1) POOL_W(4); else if (grp == 2) POOL_W(8); else POOL_W(16);
#undef POOL_W
        }
    }
    SEAM(3);
    if (IN(4)) { PH_IDS;
        const float tsu = pscale[0], tsv = pscale[1];
        int tjp = gw;
        for (int un = blockIdx.x; un < 256; un += G) tjp = ret_pass<true>(lds, qb, kb, vb, Lbuf, un, tid, lane, wave, a.peer_u, a.peer_v, utab, vtab, tsu, tsv, tjp, NGW);
    }
    SEAM(4);
    if (IN(5)) { PH_IDS;
        const bool ln_first = (blockIdx.x & 1) != 0;
        if (ln_first) {
        for (int un0 = gw * 4; un0 < S * RH; un0 += NGW * 4) {
            u32x4 yv[4]; u32x2 gv[4];
#pragma unroll
            for (int q = 0; q < 4; ++q) { const int un = un0 + q; const size_t off = (size_t)(un >> 3) * 4096 + (un & 7) * 512 + 8 * lane; yv[q] = __builtin_nontemporal_load((const u32x4*)(vb + off)); gv[q] = __builtin_nontemporal_load((const u32x2*)(gret + off)); }
#pragma unroll
            for (int q = 0; q < 4; ++q) {
                const int un = un0 + q, h = un & 7;
                float y[8] = {bf_lo(yv[q].x), bf_hi(yv[q].x), bf_lo(yv[q].y), bf_hi(yv[q].y), bf_lo(yv[q].z), bf_hi(yv[q].z), bf_lo(yv[q].w), bf_hi(yv[q].w)};
                float s1 = 0.f;
#pragma unroll
                for (int e = 0; e < 8; ++e) s1 += y[e];
                const float mean = wave_sum(s1) * (1.0f / 512.0f);
                float s2 = 0.f;
#pragma unroll
                for (int e = 0; e < 8; ++e) { y[e] -= mean; s2 += y[e] * y[e]; }
                const float rstd = 1.0f / sqrtf(wave_sum(s2) * (1.0f / 512.0f) + EPS);
                const f32x2 ga = __builtin_amdgcn_cvt_pk_f32_fp8((int)gv[q].x, false), gb = __builtin_amdgcn_cvt_pk_f32_fp8((int)gv[q].x, true), gc = __builtin_amdgcn_cvt_pk_f32_fp8((int)gv[q].y, false), gd = __builtin_amdgcn_cvt_pk_f32_fp8((int)gv[q].y, true);
                const float gg[8] = {ga.x, ga.y, gb.x, gb.y, gc.x, gc.y, gd.x, gd.y};
                const f32x4 n0 = *(const f32x4*)(a.ret_norm_gain + h * 512 + 8 * lane), n1 = *(const f32x4*)(a.ret_norm_gain + h * 512 + 8 * lane + 4);
                const float nn[8] = {n0.x, n0.y, n0.z, n0.w, n1.x, n1.y, n1.z, n1.w};
                float o[8];
#pragma unroll
                for (int e = 0; e < 8; ++e) o[e] = y[e] * rstd * nn[e] * gg[e];
                int w0 = __builtin_amdgcn_cvt_pk_fp8_f32(o[0] * 8.0f, o[1] * 8.0f, 0, false); w0 = __builtin_amdgcn_cvt_pk_fp8_f32(o[2] * 8.0f, o[3] * 8.0f, w0, true);
                int w1 = __builtin_amdgcn_cvt_pk_fp8_f32(o[4] * 8.0f, o[5] * 8.0f, 0, false); w1 = __builtin_amdgcn_cvt_pk_fp8_f32(o[6] * 8.0f, o[7] * 8.0f, w1, true);
                u32x2 w; w.x = (unsigned)w0; w.y = (unsigned)w1;
                *(u32x2*)(ret8 + (size_t)(un >> 3) * 4096 + h * 512 + 8 * lane) = w;
            }
        }
        }
        { pg8::Gemm g{pooled, WpcT, S, D, D}; pg8::StaticOrder so; so.init(S, D, G, (int)blockIdx.x);
          EpiGate<0> E{sap, merged}; pg8::gemm_phase<EpiGate<0>>(lds, g, so, E, wave); }
        if (!ln_first) {
        for (int un0 = gw * 4; un0 < S * RH; un0 += NGW * 4) {
            u32x4 yv[4]; u32x2 gv[4];
#pragma unroll
            for (int q = 0; q < 4; ++q) { const int un = un0 + q; const size_t off = (size_t)(un >> 3) * 4096 + (un & 7) * 512 + 8 * lane; yv[q] = __builtin_nontemporal_load((const u32x4*)(vb + off)); gv[q] = __builtin_nontemporal_load((const u32x2*)(gret + off)); }
#pragma unroll
            for (int q = 0; q < 4; ++q) {
                const int un = un0 + q, h = un & 7;
                float y[8] = {bf_lo(yv[q].x), bf_hi(yv[q].x), bf_lo(yv[q].y), bf_hi(yv[q].y), bf_lo(yv[q].z), bf_hi(yv[q].z), bf_lo(yv[q].w), bf_hi(yv[q].w)};
                float s1 = 0.f;
#pragma unroll
                for (int e = 0; e < 8; ++e) s1 += y[e];
                const float mean = wave_sum(s1) * (1.0f / 512.0f);
                float s2 = 0.f;
#pragma unroll
                for (int e = 0; e < 8; ++e) { y[e] -= mean; s2 += y[e] * y[e]; }
                const float rstd = 1.0f / sqrtf(wave_sum(s2) * (1.0f / 512.0f) + EPS);
                const f32x2 ga = __builtin_amdgcn_cvt_pk_f32_fp8((int)gv[q].x, false), gb = __builtin_amdgcn_cvt_pk_f32_fp8((int)gv[q].x, true), gc = __builtin_amdgcn_cvt_pk_f32_fp8((int)gv[q].y, false), gd = __builtin_amdgcn_cvt_pk_f32_fp8((int)gv[q].y, true);
                const float gg[8] = {ga.x, ga.y, gb.x, gb.y, gc.x, gc.y, gd.x, gd.y};
                const f32x4 n0 = *(const f32x4*)(a.ret_norm_gain + h * 512 + 8 * lane), n1 = *(const f32x4*)(a.ret_norm_gain + h * 512 + 8 * lane + 4);
                const float nn[8] = {n0.x, n0.y, n0.z, n0.w, n1.x, n1.y, n1.z, n1.w};
                float o[8];
#pragma unroll
                for (int e = 0; e < 8; ++e) o[e] = y[e] * rstd * nn[e] * gg[e];
                int w0 = __builtin_amdgcn_cvt_pk_fp8_f32(o[0] * 8.0f, o[1] * 8.0f, 0, false); w0 = __builtin_amdgcn_cvt_pk_fp8_f32(o[2] * 8.0f, o[3] * 8.0f, w0, true);
                int w1 = __builtin_amdgcn_cvt_pk_fp8_f32(o[4] * 8.0f, o[5] * 8.0f, 0, false); w1 = __builtin_amdgcn_cvt_pk_fp8_f32(o[6] * 8.0f, o[7] * 8.0f, w1, true);
                u32x2 w; w.x = (unsigned)w0; w.y = (unsigned)w1;
                *(u32x2*)(ret8 + (size_t)(un >> 3) * 4096 + h * 512 + 8 * lane) = w;
            }
        }
        }
    }
    SEAM(5);
    if (IN(6)) { PH_IDS;
        { pg8::Gemm g{(const bf16_t*)ret8, PretT, S, D, VW}; pg8::StaticOrder so; so.init(S, D, G, (int)blockIdx.x);
          EpiGate<1> E{sar, merged}; pg8::gemm_phase<EpiGate<1>, true, true, true>(lds, g, so, E, wave); }
    }
    SEAM(6);
    if (IN(7)) { PH_IDS;
        pg8::Gemm g{merged, WoutT, S, D, D}; pg8::StaticOrder so; so.init(S, D, G, (int)blockIdx.x);
        EpiRes E{a.x, a.out, modacc, a.b_ada}; pg8::gemm_phase<EpiRes>(lds, g, so, E, wave);
    }
    SEAM(7);
    if (IN(8)) { PH_IDS;
        LAS float* ml = (LAS float*)lds;
        for (int i = launder(tid); i < 2 * D; i += 512) ml[i] = modval(modacc, a.b_ada, 3 * D + i);
        __syncthreads();
        for (int m = gw * 2; m < S; m += NGW * 2) norm_mod_row2<(PEER_UMFMA != 0)>(a.out + (size_t)m * D, a.out + (size_t)(m + 1) * D, a.norm_ffn_gain, ml, ml + D, fn + (size_t)m * D, fn + (size_t)(m + 1) * D, lane, fn8 + (size_t)m * D, fn8 + (size_t)(m + 1) * D);
#if TAB_IN_RET
        for (int p = gw + NGW * ((((int)blockIdx.x < 256) ? (255 - (int)blockIdx.x) / G + 1 : 0) * RNCH); p < NHP; p += NGW) {
            const float* src = tab_src(a.peer_u, a.peer_v, p) + 16 * lane;
            f32x4 xv[4];
#pragma unroll
            for (int q = 0; q < 4; ++q) xv[q] = *(const f32x4*)(src + 4 * q);
            tab4_half_store(xv, pscale[(p >= 2 * NE) ? 1 : 0], tab_lane_dst(utab, vtab, p, lane));
        }
#endif
        for (int pk = gw; pk < (TAB_IN_RET ? 0 : NE * 2); pk += NGW) {
            const int row = pk >> 1, isv = pk & 1; const float* src = (isv ? a.peer_v : a.peer_u) + (size_t)row * D + 32 * lane; const float scl = pscale[isv];
            const bool f4 = isv ? (PEER_VFP4 != 0) : (PEER_UFP4 != 0);
            f32x4 xv[8];
#pragma unroll
            for (int q = 0; q < 8; ++q) xv[q] = *(const f32x4*)(src + 4 * q);
            if (f4) {
                unsigned char* dst = (isv ? vtab : utab) + (size_t)row * 1024 + 16 * lane;
                unsigned w[4] = {0u, 0u, 0u, 0u};
#pragma unroll
                for (int i = 0; i < 32; ++i) {
                    const float v = xv[i >> 2][i & 3] * scl; const float m = fminf(fabsf(v), 6.0f);
                    const float cf = (m < 2.0f) ? rintf(m * 2.0f) : ((m < 4.0f) ? 2.0f + rintf(m) : 4.0f + rintf(m * 0.5f));
                    const unsigned code = (unsigned)(int)cf | ((v < 0.0f) ? 8u : 0u);
                    w[i >> 3] |= code << (4 * (i & 7));
                }
                u32x4 o; o.x = w[0]; o.y = w[1]; o.z = w[2]; o.w = w[3]; *(u32x4*)dst = o;
            } else {
                unsigned char* dst = (isv ? vtab : utab) + (size_t)row * 1536 + 8 * lane;
                unsigned w[6] = {0u, 0u, 0u, 0u, 0u, 0u};
#pragma unroll
                for (int i = 0; i < 32; ++i) {
                    const float v = xv[i >> 2][i & 3] * scl; const float m = fminf(fabsf(v), 7.5f);
                    const float cf = (m < 2.0f) ? rintf(m * 8.0f) : ((m < 4.0f) ? 8.0f + rintf(m * 4.0f) : 16.0f + rintf(m * 2.0f));
                    const unsigned code = (unsigned)(int)cf | ((v < 0.0f) ? 32u : 0u);
                    const int pos = 6 * i, d = pos >> 5, sh = pos & 31;
                    w[d] |= code << sh;
                    if (sh > 26) w[d + 1] |= code >> (32 - sh);
                }
                u32x2 o; o.x = w[0]; o.y = w[1]; *(u32x2*)dst = o; o.x = w[2]; o.y = w[3]; *(u32x2*)(dst + 512) = o; o.x = w[4]; o.y = w[5]; *(u32x2*)(dst + 1024) = o;
            }
        }
    }
    SEAM(8);
    if (IN(9)) { PH_IDS;
        pg8::Gemm g{fn, WqsT, S, D, D}; pg8::StaticOrder so; so.init(S, D, G, (int)blockIdx.x);
        EpiBf16Plain E{(bf16_t*)scores}; pg8::gemm_phase<EpiBf16Plain>(lds, g, so, E, wave);
    }
    SEAM(9);
    if (IN(10)) { PH_IDS;
        LAS int* keys = (LAS int*)(lds + wave * 16384);
        LAS int* exl = (LAS int*)(lds + wave * 16384 + 8192);
        LAS float* gtl = (LAS float*)(lds + wave * 16384 + 12288);
        LAS float* g2l = (LAS float*)(lds + 131072);
        const float uinv = pscale[2], vinv = pscale[3];
#if PEER_VSPLIT
        { unsigned* ssq_ = (unsigned*)(ws + WS_Q + 8 * MiB);
          for (int i = blockIdx.x * 512 + tid; i < S * 8; i += G * 512) ssq_[i] = 0xFFFFFFFFu; }
#endif
        for (int i = launder(tid); i < D; i += 512) g2l[(((i & 31) >> 2) * 64 + (i >> 5)) * 4 + (i & 3)] = modval(modacc, a.b_ada, 5 * D + i);
        __syncthreads();
#define INS16(arr, xin) do { int x_ = (xin); _Pragma("unroll") for (int p_ = 0; p_ < 16; ++p_) { const int hi_ = arr[p_] > x_ ? arr[p_] : x_; x_ = arr[p_] > x_ ? x_ : arr[p_]; arr[p_] = hi_; } } while (0)
        for (int wt = gw; wt < S / 8; wt += NGW) {
            {
                const int tl = lane >> 3, hh = lane & 7;
                const bf16_t* sp = (const bf16_t*)scores + (size_t)(wt * 8 + tl) * 2048 + hh * 256;
                int tv0[16], tv1[16];
#pragma unroll
                for (int p_ = 0; p_ < 16; ++p_) { tv0[p_] = (int)0x80000000; tv1[p_] = (int)0x80000000; }
#pragma unroll 1
                for (int i8 = 0; i8 < 16; ++i8) {
                    const u32x4 w0 = __builtin_nontemporal_load((const u32x4*)(sp + 8 * i8)), w1 = __builtin_nontemporal_load((const u32x4*)(sp + 128 + 8 * i8));
                    const float v0[8] = {bf_lo(w0.x), bf_hi(w0.x), bf_lo(w0.y), bf_hi(w0.y), bf_lo(w0.z), bf_hi(w0.z), bf_lo(w0.w), bf_hi(w0.w)};
                    const float v1[8] = {bf_lo(w1.x), bf_hi(w1.x), bf_lo(w1.y), bf_hi(w1.y), bf_lo(w1.z), bf_hi(w1.z), bf_lo(w1.w), bf_hi(w1.w)};
#pragma unroll
                    for (int e = 0; e < 8; ++e) {
                        const int tag = 127 - (8 * i8 + e);
                        INS16(tv0, (okey(v0[e]) & ~127) | tag);
                        INS16(tv1, (okey(v1[e]) & ~127) | tag);
                    }
                }
                float fv0[16], fv1[16];
#pragma unroll
                for (int p_ = 0; p_ < 16; ++p_) { fv0[p_] = okey_inv(tv0[p_] & ~127); fv1[p_] = okey_inv(tv1[p_] & ~127); keys[p_ * 64 + lane] = tv0[p_]; keys[(16 + p_) * 64 + lane] = tv1[p_]; }
                int best[16];
#pragma unroll
                for (int p_ = 0; p_ < 16; ++p_) best[p_] = (int)0x80000000;
#pragma unroll
                for (int ca = 0; ca < 16; ++ca)
#pragma unroll
                    for (int cb = 0; cb < 16; ++cb)
                        if ((ca + 1) * (cb + 1) <= 16) INS16(best, (okey(fv0[ca] + fv1[cb]) & ~255) | (255 - (ca * 16 + cb)));
                float ev[16]; float den = 0.f;
                const float mx = okey_inv(best[0] & ~255);
#pragma unroll
                for (int r = 0; r < 16; ++r) { ev[r] = __expf(okey_inv(best[r] & ~255) - mx); den += ev[r]; }
                const float inv = 1.0f / den;
                LDS_WAIT();
#pragma unroll
                for (int r = 0; r < 16; ++r) {
                    const int code = 255 - (best[r] & 255);
                    const int k0 = keys[(code >> 4) * 64 + lane], k1 = keys[(16 + (code & 15)) * 64 + lane];
                    exl[tl * 128 + hh * 16 + r] = (127 - (k0 & 127)) * 128 + (127 - (k1 & 127));
                    gtl[tl * 128 + hh * 16 + r] = ev[r] * inv;
                }
                LDS_WAIT();
            }
            LAS float* dots = (LAS float*)keys;
            for (int tl = 0; tl < 8; ++tl) {
                const int t = wt * 8 + tl;
                const LAS int* ex = exl + tl * 128; LAS float* gt = gtl + tl * 128;
                float xr[32];
#pragma unroll
                for (int q = 0; q < 4; ++q) { const u32x4 w = __builtin_nontemporal_load((const u32x4*)(fn + (size_t)t * 2048 + 32 * lane + 8 * q));
                    xr[8 * q + 0] = bf_lo(w.x); xr[8 * q + 1] = bf_hi(w.x); xr[8 * q + 2] = bf_lo(w.y); xr[8 * q + 3] = bf_hi(w.y); xr[8 * q + 4] = bf_lo(w.z); xr[8 * q + 5] = bf_hi(w.z); xr[8 * q + 6] = bf_lo(w.w); xr[8 * q + 7] = bf_hi(w.w); }
#if PEER_F16
                h16x2 xh[16];
#pragma unroll
                for (int m = 0; m < 16; ++m) xh[m] = __builtin_convertvector((f32x2){xr[2 * m], xr[2 * m + 1]}, h16x2);
#endif
#define ISSUE6(buf, tab, k0) do { _Pragma("unroll") for (int i_ = 0; i_ < 4; ++i_) { const int e_ = __builtin_amdgcn_readfirstlane(ex[(k0) + i_]); \
                    const unsigned char* rp_ = (tab) + (size_t)e_ * 1536 + 8 * lane; buf[i_][0] = *(const u32x2*)rp_; buf[i_][1] = *(const u32x2*)(rp_ + 512); buf[i_][2] = *(const u32x2*)(rp_ + 1024); } } while (0)
#define ISSUE4(buf, tab, k0) do { _Pragma("unroll") for (int i_ = 0; i_ < 4; ++i_) { const int e_ = __builtin_amdgcn_readfirstlane(ex[(k0) + i_]); \
                    buf[i_] = *(const u32x4*)((tab) + (size_t)e_ * 1024 + 16 * lane); } } while (0)
#define CVT6(buf, i_) __builtin_amdgcn_cvt_scalef32_pk32_f32_fp6((u32x6){buf[i_][0].x, buf[i_][0].y, buf[i_][1].x, buf[i_][1].y, buf[i_][2].x, buf[i_][2].y}, 1.0f)
#define ROWDOT6(buf, i_, res) do { const f32x32 v_ = CVT6(buf, i_); float a0_ = 0.f, a1_ = 0.f; \
                    _Pragma("unroll") for (int m_ = 0; m_ < 32; m_ += 2) { a0_ += v_[m_] * xr[m_]; a1_ += v_[m_ + 1] * xr[m_ + 1]; } res = a0_ + a1_; } while (0)
#define ROWDOT4(buf, i_, res) do { float a0_ = 0.f, a1_ = 0.f; \
                    _Pragma("unroll") for (int q_ = 0; q_ < 4; ++q_) { const unsigned w_ = buf[i_][q_]; \
                        { const f32x2 p_ = __builtin_amdgcn_cvt_scalef32_pk_f32_fp4(w_, 1.0f, 0); a0_ += p_.x * xr[8 * q_ + 0]; a1_ += p_.y * xr[8 * q_ + 1]; } \
                        { const f32x2 p_ = __builtin_amdgcn_cvt_scalef32_pk_f32_fp4(w_, 1.0f, 1); a0_ += p_.x * xr[8 * q_ + 2]; a1_ += p_.y * xr[8 * q_ + 3]; } \
                        { const f32x2 p_ = __builtin_amdgcn_cvt_scalef32_pk_f32_fp4(w_, 1.0f, 2); a0_ += p_.x * xr[8 * q_ + 4]; a1_ += p_.y * xr[8 * q_ + 5]; } \
                        { const f32x2 p_ = __builtin_amdgcn_cvt_scalef32_pk_f32_fp4(w_, 1.0f, 3); a0_ += p_.x * xr[8 * q_ + 6]; a1_ += p_.y * xr[8 * q_ + 7]; } } res = a0_ + a1_; } while (0)
#define ROWAXPY6(buf, i_, cf_) do { const f32x32 v_ = CVT6(buf, i_); _Pragma("unroll") for (int m_ = 0; m_ < 32; ++m_) oa[m_] += v_[m_] * cf_; } while (0)
#define ROWAXPY4(buf, i_, cf_) do { _Pragma("unroll") for (int q_ = 0; q_ < 4; ++q_) { const unsigned w_ = buf[i_][q_]; \
                        { const f32x2 p_ = __builtin_amdgcn_cvt_scalef32_pk_f32_fp4(w_, 1.0f, 0); oa[8 * q_ + 0] += p_.x * cf_; oa[8 * q_ + 1] += p_.y * cf_; } \
                        { const f32x2 p_ = __builtin_amdgcn_cvt_scalef32_pk_f32_fp4(w_, 1.0f, 1); oa[8 * q_ + 2] += p_.x * cf_; oa[8 * q_ + 3] += p_.y * cf_; } \
                        { const f32x2 p_ = __builtin_amdgcn_cvt_scalef32_pk_f32_fp4(w_, 1.0f, 2); oa[8 * q_ + 4] += p_.x * cf_; oa[8 * q_ + 5] += p_.y * cf_; } \
                        { const f32x2 p_ = __builtin_amdgcn_cvt_scalef32_pk_f32_fp4(w_, 1.0f, 3); oa[8 * q_ + 6] += p_.x * cf_; oa[8 * q_ + 7] += p_.y * cf_; } } } while (0)
#if PEER_F16
#define CVT6H(buf, i_) __builtin_amdgcn_cvt_scalef32_pk32_f16_fp6((u32x6){buf[i_][0].x, buf[i_][0].y, buf[i_][1].x, buf[i_][1].y, buf[i_][2].x, buf[i_][2].y}, 1.0f)
#define H2AT(v_, m_) ((h16x2){(v_)[2 * (m_)], (v_)[2 * (m_) + 1]})
#undef ROWDOT6
#undef ROWDOT4
#undef ROWAXPY6
#undef ROWAXPY4
#define ROWDOT6(buf, i_, res) do { const h16x32 v_ = CVT6H(buf, i_); float a0_ = 0.f, a1_ = 0.f; \
                    _Pragma("unroll") for (int m_ = 0; m_ < 16; m_ += 2) { a0_ = __builtin_amdgcn_fdot2(H2AT(v_, m_), xh[m_], a0_, false); a1_ = __builtin_amdgcn_fdot2(H2AT(v_, m_ + 1), xh[m_ + 1], a1_, false); } res = a0_ + a1_; } while (0)
#define ROWDOT4(buf, i_, res) do { float a0_ = 0.f, a1_ = 0.f; \
                    _Pragma("unroll") for (int q_ = 0; q_ < 4; ++q_) { const unsigned w_ = buf[i_][q_]; \
                        a0_ = __builtin_amdgcn_fdot2(__builtin_amdgcn_cvt_scalef32_pk_f16_fp4(w_, 1.0f, 0), xh[4 * q_ + 0], a0_, false); a1_ = __builtin_amdgcn_fdot2(__builtin_amdgcn_cvt_scalef32_pk_f16_fp4(w_, 1.0f, 1), xh[4 * q_ + 1], a1_, false); \
                        a0_ = __builtin_amdgcn_fdot2(__builtin_amdgcn_cvt_scalef32_pk_f16_fp4(w_, 1.0f, 2), xh[4 * q_ + 2], a0_, false); a1_ = __builtin_amdgcn_fdot2(__builtin_amdgcn_cvt_scalef32_pk_f16_fp4(w_, 1.0f, 3), xh[4 * q_ + 3], a1_, false); } res = a0_ + a1_; } while (0)
#define ROWAXPY6(buf, i_, cf_) do { const h16x32 v_ = CVT6H(buf, i_); const h16x2 c2_ = {(_Float16)(cf_), (_Float16)(cf_)}; \
                    _Pragma("unroll") for (int m_ = 0; m_ < 16; ++m_) oh[m_] = H2AT(v_, m_) * c2_ + oh[m_]; } while (0)
#define ROWAXPY4(buf, i_, cf_) do { const h16x2 c2_ = {(_Float16)(cf_), (_Float16)(cf_)}; \
                    _Pragma("unroll") for (int q_ = 0; q_ < 4; ++q_) { const unsigned w_ = buf[i_][q_]; \
                        oh[4 * q_ + 0] = __builtin_amdgcn_cvt_scalef32_pk_f16_fp4(w_, 1.0f, 0) * c2_ + oh[4 * q_ + 0]; oh[4 * q_ + 1] = __builtin_amdgcn_cvt_scalef32_pk_f16_fp4(w_, 1.0f, 1) * c2_ + oh[4 * q_ + 1]; \
                        oh[4 * q_ + 2] = __builtin_amdgcn_cvt_scalef32_pk_f16_fp4(w_, 1.0f, 2) * c2_ + oh[4 * q_ + 2]; oh[4 * q_ + 3] = __builtin_amdgcn_cvt_scalef32_pk_f16_fp4(w_, 1.0f, 3) * c2_ + oh[4 * q_ + 3]; } } while (0)
#endif
#if PEER_UFP4
                u32x4 ua[4], ub[4], uc[4];
#define U_ISSUE ISSUE4
#define U_ROWDOT ROWDOT4
#else
                u32x2 ua[4][3], ub[4][3], uc[4][3];
#define U_ISSUE ISSUE6
#define U_ROWDOT ROWDOT6
#endif
#if PEER_VFP4
                u32x4 va[4], vbb[4], vc[4];
#define V_ISSUE ISSUE4
#define V_ROWAXPY ROWAXPY4
#else
                u32x2 va[4][3], vbb[4][3], vc[4][3];
#define V_ISSUE ISSUE6
#define V_ROWAXPY ROWAXPY6
#endif
#define PEER_DOT(buf, k0) do { float d_[4]; _Pragma("unroll") for (int i_ = 0; i_ < 4; ++i_) U_ROWDOT(buf, i_, d_[i_]); \
                    const bool b5_ = lane & 32, b4_ = lane & 16; float k1_[2], k2_; \
                    _Pragma("unroll") for (int c_ = 0; c_ < 2; ++c_) { const float snd_ = b5_ ? d_[c_] : d_[c_ + 2]; const float rcv_ = __shfl_xor(snd_, 32); k1_[c_] = (b5_ ? d_[c_ + 2] : d_[c_]) + rcv_; } \
                    { const float snd_ = b4_ ? k1_[0] : k1_[1]; const float rcv_ = __shfl_xor(snd_, 16); k2_ = (b4_ ? k1_[1] : k1_[0]) + rcv_; } \
                    k2_ += __shfl_xor(k2_, 8); k2_ += __shfl_xor(k2_, 4); k2_ += __shfl_xor(k2_, 2); k2_ += __shfl_xor(k2_, 1); \
                    if ((lane & 15) == 0) dots[(k0) + (b5_ ? 2 : 0) + (b4_ ? 1 : 0)] = k2_; } while (0)
#define PEER_AXPY(buf, k0) do { _Pragma("unroll") for (int i_ = 0; i_ < 4; ++i_) { const float cf_ = gt[(k0) + i_]; V_ROWAXPY(buf, i_, cf_); } } while (0)
#if PEER_UMFMA && PEER_UFP4
                {
                    const int r16 = lane & 15, kb = lane >> 4;
                    unsigned eoff[8];
#pragma unroll
                    for (int tile = 0; tile < 8; ++tile) eoff[tile] = (unsigned)ex[tile * 16 + r16] * 1024u + 16u * (unsigned)kb;
                    LAS unsigned char* f8l = (LAS unsigned char*)keys + 4096;
                    { const pg8::i32x4_t f0_ = *(const pg8::i32x4_t*)(fn8 + (size_t)t * 2048 + 32 * lane), f1_ = *(const pg8::i32x4_t*)(fn8 + (size_t)t * 2048 + 32 * lane + 16);
                      *(LAS pg8::i32x4_t*)(f8l + 32 * lane) = f0_; *(LAS pg8::i32x4_t*)(f8l + 32 * lane + 16) = f1_; }
                    LDS_WAIT();
                    const LAS unsigned char* f8 = f8l + 16 * kb;
#define ULOAD2(A0, A1, sidx, tb) do { const unsigned char* ul_ = utab + 64 * (sidx); _Pragma("unroll") for (int q_ = 0; q_ < 4; ++q_) { \
                        A0[q_] = *(const pg8::i32x4_t*)(ul_ + eoff[(tb) + q_]); A1[q_] = *(const pg8::i32x4_t*)(ul_ + 64 + eoff[(tb) + q_]); } } while (0)
#define UMMA4(AB, sidx) do { const pg8::i32x4_t b0_ = *(const LAS pg8::i32x4_t*)(f8 + 128 * (sidx)), b1_ = *(const LAS pg8::i32x4_t*)(f8 + 128 * (sidx) + 64); \
                        const pg8::i32x8_t B8_ = __builtin_shufflevector(b0_, b1_, 0, 1, 2, 3, 4, 5, 6, 7); \
                        _Pragma("unroll") for (int q_ = 0; q_ < 4; ++q_) { const pg8::i32x4_t a4_ = AB[q_]; const pg8::i32x8_t A8_ = {a4_.x, a4_.y, a4_.z, a4_.w, 0, 0, 0, 0}; \
                            uacc[q_] = __builtin_amdgcn_mfma_scale_f32_16x16x128_f8f6f4(A8_, B8_, uacc[q_], 4, 0, 0, 0x7F7F7F7F, 0, 0x7C7C7C7C); } } while (0)
#pragma unroll 1
                    for (int tb_ = 0; tb_ < 8; tb_ += 4) {
                        f32x4 uacc[4];
#pragma unroll
                        for (int q_ = 0; q_ < 4; ++q_) uacc[q_] = (f32x4){0.f, 0.f, 0.f, 0.f};
                        pg8::i32x4_t pa0[4], pa1[4], pb0[4], pb1[4];
                        unsigned eo_[4];
#pragma unroll
                        for (int q_ = 0; q_ < 4; ++q_) eo_[q_] = tb_ ? eoff[4 + q_] : eoff[q_];
#define ULOADP(A0, A1, sidx) do { const unsigned char* ul_ = utab + 64 * (sidx); _Pragma("unroll") for (int q_ = 0; q_ < 4; ++q_) { \
                            A0[q_] = *(const pg8::i32x4_t*)(ul_ + eo_[q_]); A1[q_] = *(const pg8::i32x4_t*)(ul_ + 64 + eo_[q_]); } } while (0)
                        ULOADP(pa0, pa1, 0);
#pragma unroll 1
                        for (int sp_ = 0; sp_ < 16; sp_ += 4) {
                            ULOADP(pb0, pb1, sp_ + 2);
                            UMMA4(pa0, sp_); UMMA4(pa1, sp_ + 1); __builtin_amdgcn_sched_barrier(0);
                            if (sp_ + 4 < 16) ULOADP(pa0, pa1, sp_ + 4);
                            UMMA4(pb0, sp_ + 2); UMMA4(pb1, sp_ + 3); __builtin_amdgcn_sched_barrier(0);
                        }
#undef ULOADP
                        if (r16 == 0) {
#pragma unroll
                            for (int q_ = 0; q_ < 4; ++q_) *(LAS f32x4*)(dots + (tb_ + q_) * 16 + 4 * kb) = uacc[q_];
                        }
                    }
#undef ULOAD2
#undef UMMA4

                }
#elif PEER_DEPTH3
                U_ISSUE(ua, utab, 0); U_ISSUE(ub, utab, 4);
#pragma unroll 1
                for (int k0 = 0; k0 < 120; k0 += 12) {
                    U_ISSUE(uc, utab, k0 + 8);
                    PEER_DOT(ua, k0);
                    U_ISSUE(ua, utab, k0 + 12);
                    PEER_DOT(ub, k0 + 4);
                    U_ISSUE(ub, utab, k0 + 16);
                    PEER_DOT(uc, k0 + 8);
                }
                PEER_DOT(ua, 120); PEER_DOT(ub, 124);
#else
                U_ISSUE(ua, utab, 0);
#pragma unroll 1
                for (int k0 = 0; k0 < 128; k0 += 8) {
                    U_ISSUE(ub, utab, k0 + 4);
                    PEER_DOT(ua, k0);
                    if (k0 + 8 < 128) U_ISSUE(ua, utab, k0 + 8);
                    PEER_DOT(ub, k0 + 4);
                }
#endif
                LDS_WAIT();
#pragma unroll
                for (int hf = 0; hf < 2; ++hf) { const int kk = lane + 64 * hf; const float dv = dots[kk] * uinv;
                    const float z = 1.5957691216057308f * (dv + 0.044715f * dv * dv * dv);
                    gt[kk] = gt[kk] * dv * sigmoidf_(z);
#if PEER_VSPLIT
                    { const int pos_ = (kk & 7) * 16 + (kk >> 3);
                      ((unsigned short*)(ws + WS_Q))[(size_t)t * 128 + pos_] = (unsigned short)ex[kk];
                      ((_Float16*)(ws + WS_Q + 4 * MiB))[(size_t)t * 128 + pos_] = (_Float16)gt[kk];
                      { const int c8_ = __builtin_amdgcn_cvt_pk_fp8_f32(gt[kk] * 8.0f, 0.0f, 0, false); (ws + WS_Q + 12 * MiB)[(size_t)t * 128 + kk] = (unsigned char)(c8_ & 0xff); } }
#endif
                }
#if PEER_VSPLIT
                LDS_WAIT();
                continue;
#endif
                LDS_WAIT();
#if PEER_F16
                h16x2 oh[16];
#pragma unroll
                for (int m = 0; m < 16; ++m) oh[m] = (h16x2){(_Float16)0.f, (_Float16)0.f};
#else
                float oa[32];
#pragma unroll
                for (int m = 0; m < 32; ++m) oa[m] = 0.f;
#endif
#if PEER_DEPTH3
                V_ISSUE(va, vtab, 0); V_ISSUE(vbb, vtab, 4);
#pragma unroll 1
                for (int k0 = 0; k0 < 120; k0 += 12) {
                    V_ISSUE(vc, vtab, k0 + 8);
                    PEER_AXPY(va, k0);
                    V_ISSUE(va, vtab, k0 + 12);
                    PEER_AXPY(vbb, k0 + 4);
                    V_ISSUE(vbb, vtab, k0 + 16);
                    PEER_AXPY(vc, k0 + 8);
                }
                PEER_AXPY(va, 120); PEER_AXPY(vbb, 124);
#else
                V_ISSUE(va, vtab, 0);
#pragma unroll 1
                for (int k0 = 0; k0 < 128; k0 += 8) {
                    V_ISSUE(vbb, vtab, k0 + 4);
                    PEER_AXPY(va, k0);
                    if (k0 + 8 < 128) V_ISSUE(va, vtab, k0 + 8);
                    PEER_AXPY(vbb, k0 + 4);
                }
#endif
#if PEER_F16
                float oa[32];
#pragma unroll
                for (int m = 0; m < 16; ++m) { oa[2 * m] = (float)oh[m][0]; oa[2 * m + 1] = (float)oh[m][1]; }
#endif
                float* orow = a.out + (size_t)t * 2048 + 32 * lane;
                float ss = 0.f;
#pragma unroll
                for (int q4 = 0; q4 < 8; ++q4) {
                    const f32x4 x1 = *(const f32x4*)(orow + 4 * q4);
                    const f32x4 g2 = *(const LAS f32x4*)(g2l + (q4 * 64 + lane) * 4);
#pragma unroll
                    for (int e = 0; e < 4; ++e) { const float v2 = x1[e] + g2[e] * oa[4 * q4 + e] * vinv; oa[4 * q4 + e] = v2; ss += v2 * v2; }
                }
                const float rstd = 1.0f / sqrtf(wave_sum(ss) * (1.0f / D) + EPS);
#pragma unroll
                for (int q4 = 0; q4 < 8; ++q4) {
                    const f32x4 fg = *(const f32x4*)(a.final_norm_gain + 32 * lane + 4 * q4);
                    f32x4 o; o.x = oa[4 * q4] * rstd * fg.x; o.y = oa[4 * q4 + 1] * rstd * fg.y; o.z = oa[4 * q4 + 2] * rstd * fg.z; o.w = oa[4 * q4 + 3] * rstd * fg.w;
                    *(f32x4*)(orow + 4 * q4) = o;
                }
                LDS_WAIT();
            }
        }
#undef INS16
#undef PEER_DOT
#undef PEER_AXPY
    }

#if PEER_VSPLIT
    SEAM(10);
    if (IN(11)) { PH_IDS;
        const int xs = (int)(blockIdx.x & 7), jr = (int)(blockIdx.x >> 3);
        const int rg = lane >> 3, part = lane & 7;
        const int c0 = 256 * xs + 32 * part + 4 * rg;
        LAS unsigned char* wl = lds + wave * 16384;
        constexpr int VS_RL = 8;
        const float vinv = pscale[3];
        f32x4 g2v, fgv;
#pragma unroll
        for (int e = 0; e < 4; ++e) g2v[e] = modval(modacc, a.b_ada, 5 * D + c0 + e);
        fgv = *(const f32x4*)(a.final_norm_gain + c0);
        const unsigned short* EXT = (const unsigned short*)(ws + WS_Q); const _Float16* GTT = (const _Float16*)(ws + WS_Q + 4 * MiB);
        unsigned* SSQ = (unsigned*)(ws + WS_Q + 8 * MiB);
        const int tfirst = 512 * jr + 64 * wave;
        const unsigned char* vsl = vtab + (size_t)xs * ((size_t)NE * 128) + 16 * part;
#if PEER_VMFMA
        {
            const int r16 = lane & 15, kb = lane >> 4;
            LAS unsigned char* tl_ = lds + wave * 18432;
            LAS float* outl = (LAS float*)(tl_ + 16384);
            const unsigned tile_lds = (unsigned)__builtin_amdgcn_readfirstlane((int)(unsigned)(size_t)tl_);
            const int cm = 256 * xs + 4 * lane;
            f32x4 g2m, fgm;
#pragma unroll
            for (int e = 0; e < 4; ++e) g2m[e] = modval(modacc, a.b_ada, 5 * D + cm + e);
            fgm = *(const f32x4*)(a.final_norm_gain + cm);
            const unsigned char* GT8 = ws + WS_Q + 12 * MiB;
            const unsigned fq16 = 16u * (unsigned)((r16 >> 1) & 7);
            const unsigned rdbase = (unsigned)((32 * kb + r16) * 128);
            u32x4 cid0, cid1, cw0, cw1, nid0, nid1, nw0, nw1; f32x4 cx1, nx1;
#define VM_LOAD(T, I0, I1, W0, W1, X1) do { const size_t lo_ = (size_t)(T) * 128; \
                I0 = *(const u32x4*)(EXT + lo_ + rg * 16); I1 = *(const u32x4*)(EXT + lo_ + rg * 16 + 8); \
                W0 = *(const u32x4*)(GT8 + lo_ + 16 * kb); W1 = *(const u32x4*)(GT8 + lo_ + 64 + 16 * kb); \
                X1 = __builtin_nontemporal_load((const f32x4*)(a.out + (size_t)(T) * 2048 + cm)); } while (0)
            VM_LOAD(tfirst, cid0, cid1, cw0, cw1, cx1); VM_LOAD(tfirst + 1, nid0, nid1, nw0, nw1, nx1);
            constexpr int VS_LAG = 4;
            float* ringw = (float*)(ws + WS_V) + (size_t)((int)blockIdx.x * 8 + wave) * ((VS_LAG + 1) * 256) + 4 * lane;
#define VS_RING(TI) (ringw + ((TI) % (VS_LAG + 1)) * 256)
#define VM_DMA() do { _Pragma("unroll") for (int g = 0; g < 16; ++g) { \
                    const unsigned idw = (g < 8) ? cid0[g >> 1] : cid1[(g - 8) >> 1]; const unsigned e_ = (g & 1) ? (idw >> 16) : (idw & 0xffffu); \
                    const unsigned char* src_ = vtab + (size_t)xs * ((size_t)NE * 128) + (size_t)e_ * 128 + 16 * (part ^ ((4 * g + (rg >> 1)) & 7)); \
                    unsigned keep_; \
                    asm volatile("s_mov_b32 %0, m0\n\ts_mov_b32 m0, %2\n\ts_nop 0\n\tglobal_load_lds_dwordx4 %1, off\n\ts_mov_b32 m0, %0" : "=&s"(keep_) : "v"(src_), "s"(tile_lds + 1024u * g) : "memory"); } } while (0)
            unsigned pollv = 0xFFFFFFFFu; f32x4 xqv = (f32x4){0.f, 0.f, 0.f, 0.f};
            VM_DMA();
            asm volatile("s_waitcnt vmcnt(0)" ::: "memory");
#pragma unroll 1
            for (int i = 0; i < 64; ++i) {
                asm volatile("s_waitcnt vmcnt(9)" ::: "memory");
                const pg8::i32x8_t A8 = {(int)cw0.x, (int)cw0.y, (int)cw0.z, (int)cw0.w, (int)cw1.x, (int)cw1.y, (int)cw1.z, (int)cw1.w};
                const f32x4 x1 = cx1;
                pg8::i32x2_t bq0[16], bq1[16];
#pragma unroll
                for (int j = 0; j < 16; ++j) {
                    const unsigned ad_ = rdbase + ((16u * (unsigned)(j >> 1)) ^ fq16) + 8u * (unsigned)(j & 1);
                    bq0[j] = __builtin_amdgcn_ds_read_tr4_b64_v2i32((LAS pg8::i32x2_t*)(tl_ + ad_));
                    bq1[j] = __builtin_amdgcn_ds_read_tr4_b64_v2i32((LAS pg8::i32x2_t*)(tl_ + ad_ + 2048));
                }
                float rj[16];
#pragma unroll
                for (int j = 0; j < 16; ++j) {
                    const pg8::i32x8_t B8 = {bq0[j].x, bq0[j].y, bq1[j].x, bq1[j].y, 0, 0, 0, 0};
                    const f32x4 r_ = __builtin_amdgcn_mfma_scale_f32_16x16x128_f8f6f4(A8, B8, (f32x4){0.f, 0.f, 0.f, 0.f}, 0, 4, 0, 0x7C7C7C7C, 0, 0x7F7F7F7F);
                    rj[j] = r_[0];
                }
#pragma unroll
                for (int j = 0; j < 16; ++j) outl[16 * j + r16] = rj[j];
                LDS_WAIT();
                if (i >= VS_LAG) {
                    const int tt = i - VS_LAG;
                    { unsigned sp_ = 0; while (pollv == 0xFFFFFFFFu && ++sp_ < (1u << 22)) pollv = __hip_atomic_load(SSQ + (size_t)(tfirst + tt) * 8 + part, __ATOMIC_RELAXED, __HIP_MEMORY_SCOPE_AGENT); }
                    float tot = 0.f;
#pragma unroll
                    for (int k_ = 0; k_ < 8; ++k_) tot += __builtin_bit_cast(float, __shfl((int)pollv, k_));
                    const float rstd = 1.0f / sqrtf(tot * (1.0f / D) + EPS);
                    f32x4 o_; o_.x = xqv.x * rstd * fgm.x; o_.y = xqv.y * rstd * fgm.y; o_.z = xqv.z * rstd * fgm.z; o_.w = xqv.w * rstd * fgm.w;
                    __builtin_nontemporal_store(o_, (f32x4*)(a.out + (size_t)(tfirst + tt) * 2048 + cm));
                }
                cid0 = nid0; cid1 = nid1; cw0 = nw0; cw1 = nw1; cx1 = nx1;
                __builtin_amdgcn_sched_barrier(0);
                if (i + 1 < 64) VM_DMA();
                pollv = __hip_atomic_load(SSQ + (size_t)(tfirst + ((i + 1 >= VS_LAG) ? i + 1 - VS_LAG : 0)) * 8 + part, __ATOMIC_RELAXED, __HIP_MEMORY_SCOPE_AGENT);
                xqv = *(const f32x4*)VS_RING((i + 1 >= VS_LAG) ? i + 1 - VS_LAG : 0);
                { const int tn_ = tfirst + ((i + 2 < 64) ? i + 2 : 63); VM_LOAD(tn_, nid0, nid1, nw0, nw1, nx1); }
                __builtin_amdgcn_sched_barrier(0);
                const f32x4 acc4 = *(const LAS f32x4*)(outl + 4 * lane);
                f32x4 x2; float ss = 0.f;
#pragma unroll
                for (int e = 0; e < 4; ++e) { x2[e] = x1[e] + g2m[e] * acc4[e] * vinv; ss += x2[e] * x2[e]; }
                ss = wave_sum(ss);
                if (lane == 0) __hip_atomic_store(SSQ + (size_t)(tfirst + i) * 8 + xs, __builtin_bit_cast(unsigned, ss), __ATOMIC_RELAXED, __HIP_MEMORY_SCOPE_AGENT);
                *(f32x4*)VS_RING(i) = x2;
            }
            asm volatile("s_waitcnt vmcnt(0)" ::: "memory");
            for (int i = 64; i < 64 + VS_LAG; ++i) {
                const int tt = i - VS_LAG;
                { unsigned sp_ = 0; while (pollv == 0xFFFFFFFFu && ++sp_ < (1u << 22)) pollv = __hip_atomic_load(SSQ + (size_t)(tfirst + tt) * 8 + part, __ATOMIC_RELAXED, __HIP_MEMORY_SCOPE_AGENT); }
                float tot = 0.f;
#pragma unroll
                for (int k_ = 0; k_ < 8; ++k_) tot += __builtin_bit_cast(float, __shfl((int)pollv, k_));
                const float rstd = 1.0f / sqrtf(tot * (1.0f / D) + EPS);
                f32x4 o_; o_.x = xqv.x * rstd * fgm.x; o_.y = xqv.y * rstd * fgm.y; o_.z = xqv.z * rstd * fgm.z; o_.w = xqv.w * rstd * fgm.w;
                __builtin_nontemporal_store(o_, (f32x4*)(a.out + (size_t)(tfirst + tt) * 2048 + cm));
                if (i + 1 < 64 + VS_LAG) { pollv = __hip_atomic_load(SSQ + (size_t)(tfirst + i + 1 - VS_LAG) * 8 + part, __ATOMIC_RELAXED, __HIP_MEMORY_SCOPE_AGENT);
                                           xqv = *(const f32x4*)VS_RING(i + 1 - VS_LAG); }
            }
#undef VM_DMA
#undef VS_RING
#undef VM_LOAD
        }
#else
        u32x4 idA0, idA1, wA0, wA1, idB0, idB1, wB0, wB1;
#define VS_LOADIDS(T, I0, I1, W0, W1) do { const size_t lo_ = (size_t)(T) * 128 + rg * 16; \
            I0 = *(const u32x4*)(EXT + lo_); I1 = *(const u32x4*)(EXT + lo_ + 8); W0 = *(const u32x4*)(GTT + lo_); W1 = *(const u32x4*)(GTT + lo_ + 8); } while (0)
#define VS_GATHER(VB, I0, I1) do { _Pragma("unroll") for (int g = 0; g < 16; ++g) { const unsigned idw = (g < 8) ? I0[g >> 1] : I1[(g - 8) >> 1]; const unsigned e_ = (g & 1) ? (idw >> 16) : (idw & 0xffffu); \
            VB[g] = *(const u32x4*)(vsl + (size_t)e_ * 128); } } while (0)
#define VS_TOKEN(VB, W0, W1, X1, TI) do { \
            h16x2 oh[16]; \
            _Pragma("unroll") for (int m = 0; m < 16; ++m) oh[m] = (h16x2){(_Float16)0.f, (_Float16)0.f}; \
            _Pragma("unroll") for (int g = 0; g < 16; ++g) { \
                const unsigned ww = (g < 8) ? W0[g >> 1] : W1[(g - 8) >> 1]; \
                const _Float16 cf = __builtin_bit_cast(_Float16, (unsigned short)((g & 1) ? (ww >> 16) : (ww & 0xffffu))); const h16x2 c2_ = {cf, cf};     \
                _Pragma("unroll") for (int q_ = 0; q_ < 4; ++q_) { const unsigned w_ = VB[g][q_]; \
                    oh[4 * q_ + 0] = __builtin_amdgcn_cvt_scalef32_pk_f16_fp4(w_, 1.0f, 0) * c2_ + oh[4 * q_ + 0]; oh[4 * q_ + 1] = __builtin_amdgcn_cvt_scalef32_pk_f16_fp4(w_, 1.0f, 1) * c2_ + oh[4 * q_ + 1]; \
                    oh[4 * q_ + 2] = __builtin_amdgcn_cvt_scalef32_pk_f16_fp4(w_, 1.0f, 2) * c2_ + oh[4 * q_ + 2]; oh[4 * q_ + 3] = __builtin_amdgcn_cvt_scalef32_pk_f16_fp4(w_, 1.0f, 3) * c2_ + oh[4 * q_ + 3]; } } \
            { LAS h16x2* pp = (LAS h16x2*)(wl + (rg * 8 + part) * 64); _Pragma("unroll") for (int m = 0; m < 16; ++m) pp[m] = oh[m]; }     \
            LDS_WAIT(); \
            f32x4 acc4 = (f32x4){0.f, 0.f, 0.f, 0.f}; \
            _Pragma("unroll") for (int r_ = 0; r_ < 8; ++r_) { const LAS h16x2* pr_ = (const LAS h16x2*)(wl + (r_ * 8 + part) * 64 + 8 * rg); const h16x2 pa_ = pr_[0], pb_ = pr_[1]; \
                acc4[0] += (float)pa_[0]; acc4[1] += (float)pa_[1]; acc4[2] += (float)pb_[0]; acc4[3] += (float)pb_[1]; } \
            LDS_WAIT(); \
            f32x4 x2; float ss = 0.f; \
            _Pragma("unroll") for (int e = 0; e < 4; ++e) { x2[e] = X1[e] + g2v[e] * acc4[e] * vinv; ss += x2[e] * x2[e]; } \
            ss = wave_sum(ss); \
            if (lane == 0) __hip_atomic_store(SSQ + (size_t)(tfirst + (TI)) * 8 + xs, __builtin_bit_cast(unsigned, ss), __ATOMIC_RELAXED, __HIP_MEMORY_SCOPE_AGENT); \
            *(LAS f32x4*)(wl + 4096 + ((TI) % (VS_RL + 2)) * 1024 + lane * 16) = x2; } while (0)
#define VS_FINISH(PV, TI) do {     \
            const int tt = tfirst + (TI); \
            { unsigned sp_ = 0; while (PV == 0xFFFFFFFFu && ++sp_ < (1u << 22)) PV = __hip_atomic_load(SSQ + (size_t)tt * 8 + part, __ATOMIC_RELAXED, __HIP_MEMORY_SCOPE_AGENT); } \
            float tot = 0.f; \
            _Pragma("unroll") for (int k_ = 0; k_ < 8; ++k_) tot += __builtin_bit_cast(float, __shfl((int)PV, k_));     \
            const float rstd = 1.0f / sqrtf(tot * (1.0f / D) + EPS); \
            const f32x4 x2 = *(const LAS f32x4*)(wl + 4096 + ((TI) % (VS_RL + 2)) * 1024 + lane * 16); \
            f32x4 o_; o_.x = x2.x * rstd * fgv.x; o_.y = x2.y * rstd * fgv.y; o_.z = x2.z * rstd * fgv.z; o_.w = x2.w * rstd * fgv.w; \
            *(f32x4*)(a.out + (size_t)tt * 2048 + c0) = o_; } while (0)
        VS_LOADIDS(tfirst, idA0, idA1, wA0, wA1); VS_LOADIDS(tfirst + 1, idB0, idB1, wB0, wB1);
        unsigned pollA = 0xFFFFFFFFu, pollB = 0xFFFFFFFFu;
#pragma unroll 1
        for (int i = 0; i < 64 + VS_RL; i += 2) {
            u32x4 vbA[16], vbB[16]; u32x4 cwA0, cwA1, cwB0, cwB1; f32x4 x1A, x1B;
            if (i < 64) {
                VS_GATHER(vbA, idA0, idA1); VS_GATHER(vbB, idB0, idB1);
                cwA0 = wA0; cwA1 = wA1; cwB0 = wB0; cwB1 = wB1;
                x1A = *(const f32x4*)(a.out + (size_t)(tfirst + i) * 2048 + c0); x1B = *(const f32x4*)(a.out + (size_t)(tfirst + i + 1) * 2048 + c0);
                if (i + 2 < 64) { VS_LOADIDS(tfirst + i + 2, idA0, idA1, wA0, wA1); VS_LOADIDS(tfirst + i + 3, idB0, idB1, wB0, wB1); }
            }
            if (i >= VS_RL) { VS_FINISH(pollA, i - VS_RL); VS_FINISH(pollB, i + 1 - VS_RL); }
            if (i < 64) { VS_TOKEN(vbA, cwA0, cwA1, x1A, i); VS_TOKEN(vbB, cwB0, cwB1, x1B, i + 1); }
            if (i + 2 >= VS_RL && i + 2 < 64 + VS_RL) {
                pollA = __hip_atomic_load(SSQ + (size_t)(tfirst + i + 2 - VS_RL) * 8 + part, __ATOMIC_RELAXED, __HIP_MEMORY_SCOPE_AGENT);
                pollB = __hip_atomic_load(SSQ + (size_t)(tfirst + i + 3 - VS_RL) * 8 + part, __ATOMIC_RELAXED, __HIP_MEMORY_SCOPE_AGENT);
            }
        }
#undef VS_LOADIDS
#undef VS_GATHER
#undef VS_TOKEN
#undef VS_FINISH
#endif
    }
#endif
#undef IN
#undef SEAM
}

static_assert(12288 * 8 <= CTL_SCALE && CTL_BAR + XCD_BAR_WORDS * 4 <= CTL_ZERO_BYTES, "control block layout");
extern "C" void kernel_launch(void* const* d_in, const int* in_sizes, int n_in, void* d_out, int out_size, void* d_ws, size_t ws_size, hipStream_t stream) {
    static int grid = 0;
    if (grid == 0) {
        if (n_in != 19 || out_size != S * D || ws_size < WS_END) { fprintf(stderr, "kernel_launch: unexpected problem (n_in %d out %d ws %zu)\n", n_in, out_size, ws_size); grid = -1; return; }
        int dev = 0, cus = 0, per_cu = 0;
        hipGetDevice(&dev); hipDeviceGetAttribute(&cus, hipDeviceAttributeMultiprocessorCount, dev);
        hipFuncSetAttribute((const void*)mk_fwd, hipFuncAttributeMaxDynamicSharedMemorySize, LDS_BYTES);
        hipOccupancyMaxActiveBlocksPerMultiprocessor(&per_cu, (const void*)mk_fwd, 512, LDS_BYTES);
        (void)hipGetLastError();
        if (per_cu < 1) { fprintf(stderr, "kernel_launch: occupancy query says %d blocks per CU\n", per_cu); per_cu = 1; }
        grid = cus * 1;
        if (PEER_VSPLIT && grid != 256) { fprintf(stderr, "kernel_launch: the column-split PEER layer needs the 256-workgroup grid (grid %d)\n", grid); grid = -1; return; }
    }
    if (grid < 0) return;
    hipMemsetAsync((char*)d_ws + WS_CTL, 0, CTL_ZERO_BYTES, stream);
    Args a{};
    a.x = (const float*)d_in[0]; a.c = (const float*)d_in[1]; a.positions = (const int*)d_in[2]; a.norm_mix_gain = (const float*)d_in[3];
    a.w_ada = (const float*)d_in[4]; a.b_ada = (const float*)d_in[5]; a.w_in = (const float*)d_in[6]; a.pool_w = (const float*)d_in[7];
    a.pool_scale = (const float*)d_in[8]; a.ret_norm_gain = (const float*)d_in[9]; a.w_branch_pool = (const float*)d_in[10]; a.w_branch_ret = (const float*)d_in[11];
    a.w_out = (const float*)d_in[12]; a.norm_ffn_gain = (const float*)d_in[13]; a.peer_w_query = (const float*)d_in[14]; a.peer_sub_keys = (const float*)d_in[15];
    a.peer_u = (const float*)d_in[16]; a.peer_v = (const float*)d_in[17]; a.final_norm_gain = (const float*)d_in[18];
    a.out = (float*)d_out; a.ws = (unsigned char*)d_ws;
#if MK_N_LAUNCHES == 1
    a.ph_lo = 0; a.ph_hi = NPHASE;
    void* args[] = {&a};
    hipError_t e = hipLaunchCooperativeKernel((const void*)mk_fwd, dim3(grid), dim3(512), args, LDS_BYTES, stream);
    if (e != hipSuccess) fprintf(stderr, "cooperative launch failed: %s (grid %d)\n", hipGetErrorString(e), grid);
#else
    for (int p = 0; p < NPHASE; ++p) { a.ph_lo = p; a.ph_hi = p + 1; hipLaunchKernelGGL(mk_fwd, dim3(grid), dim3(512), LDS_BYTES, stream, a); }
#endif
}
```
